# Optimizing an MI355X kernel written in HIP

```python
import math
import jax, jax.numpy as jnp
from jax import lax
import numpy as np

D_MODEL = 1024
BATCH = 16
SEQ = 2048
DEPTH = 1

MEM_LEN = 256
MAX_POS_OFFSET = 1024
ML_HEADS = 4
ML_DQK = 128
ML_DV = 256
ML_CHUNK = 64
ML_CONV = 4
DA_HEADS = 8
DA_DHEAD = 64
DA_DV = 2 * DA_DHEAD
Q_BLOCK = 128
ROPE_THETA = 10000.0
XA_HEADS = 4
XA_DHEAD = D_MODEL // XA_HEADS
FFN_HIDDEN = -(-8 * D_MODEL // (3 * 256)) * 256
ALPHA = (2.0 * DEPTH) ** 0.25
BETA = (8.0 * DEPTH) ** -0.25
LN_EPS = 1e-5

ML_QK_W = 2 * ML_HEADS * ML_DQK
ML_V_W = ML_HEADS * ML_DV
ML_O_W = ML_HEADS * ML_DV
ML_IF_W = 2 * ML_HEADS
DA_Q_W = DA_HEADS * 2 * DA_DHEAD
DA_K_W = DA_HEADS * 2 * DA_DHEAD
DA_V_W = DA_HEADS * DA_DV
GATE_W = 2 * D_MODEL
IN_SIZES = (ML_QK_W, ML_V_W, ML_O_W, ML_IF_W, DA_Q_W, DA_K_W, DA_V_W, GATE_W)
IN_DIM = ML_QK_W + ML_V_W + ML_O_W + ML_IF_W + DA_Q_W + DA_K_W + DA_V_W + GATE_W
F_GATE_OFFSET = ML_QK_W + ML_V_W + ML_O_W + ML_HEADS

kernel_name = 'hybrid_mlstm_diffattn_gated_deepnorm'


def layer_norm(x, g, b):
    xf = x.astype(jnp.float32)
    mu = xf.mean(-1, keepdims=True)
    var = jnp.square(xf - mu).mean(-1, keepdims=True)
    return ((xf - mu) * lax.rsqrt(var + LN_EPS) * g + b).astype(x.dtype)


def head_layer_norm(h, g):
    mu = h.mean(-1, keepdims=True)
    var = jnp.square(h - mu).mean(-1, keepdims=True)
    return (h - mu) * lax.rsqrt(var + LN_EPS) * g


def head_rms_norm(h, g):
    hf = h.astype(jnp.float32)
    return hf * lax.rsqrt(jnp.square(hf).mean(-1, keepdims=True) + LN_EPS) * g


def causal_dwconv(x, w, b):
    K, C = w.shape
    y = lax.conv_general_dilated(x, w[:, None, :], window_strides=(1,), padding=((K - 1, 0),),
                                 dimension_numbers=('NWC', 'WIO', 'NWC'), feature_group_count=C)
    return y + b


def rope(x, pos):
    half = x.shape[-1] // 2
    inv = ROPE_THETA ** (-jnp.arange(half, dtype=jnp.float32) / half)
    ang = pos.astype(jnp.float32)[..., None] * inv
    cos = jnp.cos(ang)[:, :, None, :]
    sin = jnp.sin(ang)[:, :, None, :]
    x1, x2 = x[..., :half], x[..., half:]
    return jnp.concatenate([x1 * cos - x2 * sin, x2 * cos + x1 * sin], axis=-1).astype(x.dtype)


def mlstm_chunkwise(q, k, v, i_pre, f_pre):
    B, S, H, dk = q.shape
    dv = v.shape[-1]
    L = ML_CHUNK
    nc = S // L
    f32 = jnp.float32

    def chunks(t):
        return t.astype(f32).reshape(B, nc, L, H, t.shape[-1]).transpose(1, 0, 3, 2, 4)

    def gchunks(t):
        return t.astype(f32).reshape(B, nc, L, H).transpose(1, 0, 3, 2)

    qc = chunks(q) * (dk ** -0.5)
    kc, vc = chunks(k), chunks(v)
    ic = gchunks(i_pre)
    lfc = jax.nn.log_sigmoid(gchunks(f_pre))
    causal = jnp.tril(jnp.ones((L, L), dtype=bool))

    def step(carry, inp):
        C, n, m = carry
        qb, kb, vb, ib, lfb = inp
        bcum = jnp.cumsum(lfb, axis=-1)
        dmat = bcum[..., :, None] - bcum[..., None, :] + ib[..., None, :]
        dmat = jnp.where(causal, dmat, -jnp.inf)
        inter = bcum + m[..., None]
        m_row = jnp.maximum(inter, dmat.max(-1))
        w_inter = jnp.exp(inter - m_row)
        w_intra = jnp.exp(dmat - m_row[..., None])
        qk = jnp.einsum('bhtd,bhsd->bhts', qb, kb) * w_intra
        num = (w_inter[..., None] * jnp.einsum('bhtd,bhdv->bhtv', qb, C)
               + jnp.einsum('bhts,bhsv->bhtv', qk, vb))
        den = w_inter * jnp.einsum('bhtd,bhd->bht', qb, n) + qk.sum(-1)
        h = num / jnp.maximum(jnp.abs(den), jnp.exp(-m_row))[..., None]
        b_last = bcum[..., -1]
        g = b_last[..., None] - bcum + ib
        m_new = jnp.maximum(b_last + m, g.max(-1))
        decay = jnp.exp(b_last + m - m_new)
        ws = jnp.exp(g - m_new[..., None])
        C_new = decay[..., None, None] * C + jnp.einsum('bhs,bhsd,bhsv->bhdv', ws, kb, vb)
        n_new = decay[..., None] * n + jnp.einsum('bhs,bhsd->bhd', ws, kb)
        return (C_new, n_new, m_new), h

    init = (jnp.zeros((B, H, dk, dv), f32), jnp.zeros((B, H, dk), f32), jnp.zeros((B, H), f32))
    _, hs = lax.scan(step, init, (qc, kc, vc, ic, lfc))
    return hs.transpose(1, 0, 3, 2, 4).reshape(B, S, H, dv)


def diff_attention(q, k, v, lam):
    B, S, H, _, d = q.shape
    dv = v.shape[-1]
    nb = S // Q_BLOCK
    qb = q.reshape(B, nb, Q_BLOCK, H, 2, d).transpose(1, 0, 3, 4, 2, 5)
    kt = k.transpose(0, 2, 3, 1, 4)
    vt = v.transpose(0, 2, 1, 3)
    kpos = jnp.arange(S)
    scale = d ** -0.5

    def block(args):
        qi, i = args
        s = jnp.einsum('bhcqd,bhckd->bhcqk', qi, kt).astype(jnp.float32) * scale
        qpos = i * Q_BLOCK + jnp.arange(Q_BLOCK)
        s = jnp.where(kpos[None, :] <= qpos[:, None], s, -jnp.inf)
        p = jax.nn.softmax(s, axis=-1)
        a = p[:, :, 0] - lam * p[:, :, 1]
        return jnp.einsum('bhqk,bhkv->bhqv', a.astype(vt.dtype), vt)

    o = lax.map(block, (qb, jnp.arange(nb)))
    return o.transpose(1, 0, 3, 2, 4).reshape(B, S, H, dv)


def setup_inputs(seed: int = 0) -> dict:
    key = jax.random.key(seed)
    ks = jax.random.split(key, 32)

    def nrm(i, shape, scale):
        return jax.random.normal(ks[i], shape, jnp.float32) * scale

    D, F = D_MODEL, FFN_HIDDEN
    x = nrm(0, (BATCH, SEQ, D), 1.0)
    mem = nrm(1, (BATCH, MEM_LEN, D), 1.0)
    offs = jax.random.randint(ks[2], (BATCH, 1), 0, MAX_POS_OFFSET, dtype=jnp.int32)
    positions = offs + jnp.arange(SEQ, dtype=jnp.int32)[None, :]
    w_in = nrm(3, (DEPTH, D, IN_DIM), D ** -0.5)
    b_in = nrm(4, (DEPTH, IN_DIM), 0.02)
    b_in = b_in.at[:, F_GATE_OFFSET:F_GATE_OFFSET + ML_HEADS].add(jnp.linspace(3.0, 6.0, ML_HEADS))
    conv_w = nrm(5, (DEPTH, ML_CONV, ML_QK_W), ML_CONV ** -0.5)
    conv_b = nrm(6, (DEPTH, ML_QK_W), 0.02)
    ml_norm_w = 1.0 + nrm(7, (DEPTH, ML_HEADS * ML_DV), 0.02)
    lam_q1 = nrm(8, (DEPTH, DA_DHEAD), 0.1)
    lam_k1 = nrm(9, (DEPTH, DA_DHEAD), 0.1)
    lam_q2 = nrm(10, (DEPTH, DA_DHEAD), 0.1)
    lam_k2 = nrm(11, (DEPTH, DA_DHEAD), 0.1)
    da_norm_w = 1.0 + nrm(12, (DEPTH, DA_HEADS * DA_DV), 0.02)
    w_proj_a = nrm(13, (DEPTH, ML_V_W, D), ML_V_W ** -0.5)
    w_proj_b = nrm(14, (DEPTH, DA_V_W, D), DA_V_W ** -0.5)
    w_mix_out = nrm(15, (DEPTH, D, D), BETA * D ** -0.5)
    ln1_g = 1.0 + nrm(16, (DEPTH, D), 0.02)
    ln1_b = nrm(17, (DEPTH, D), 0.02)
    w_xq = nrm(18, (DEPTH, D, XA_HEADS * XA_DHEAD), D ** -0.5)
    w_xk = nrm(19, (DEPTH, D, XA_HEADS * XA_DHEAD), D ** -0.5)
    w_xv = nrm(20, (DEPTH, D, XA_HEADS * XA_DHEAD), D ** -0.5)
    w_xo = nrm(21, (DEPTH, XA_HEADS * XA_DHEAD, D), BETA * (XA_HEADS * XA_DHEAD) ** -0.5)
    ln2_g = 1.0 + nrm(22, (DEPTH, D), 0.02)
    ln2_b = nrm(23, (DEPTH, D), 0.02)
    w_ffn_gate = nrm(24, (DEPTH, D, F), D ** -0.5)
    w_ffn_up = nrm(25, (DEPTH, D, F), D ** -0.5)
    w_ffn_down = nrm(26, (DEPTH, F, D), BETA * F ** -0.5)
    ln3_g = 1.0 + nrm(27, (DEPTH, D), 0.02)
    ln3_b = nrm(28, (DEPTH, D), 0.02)
    return {'x': x, 'mem': mem, 'positions': positions, 'w_in': w_in, 'b_in': b_in,
            'conv_w': conv_w, 'conv_b': conv_b, 'ml_norm_w': ml_norm_w,
            'lam_q1': lam_q1, 'lam_k1': lam_k1, 'lam_q2': lam_q2, 'lam_k2': lam_k2,
            'da_norm_w': da_norm_w, 'w_proj_a': w_proj_a, 'w_proj_b': w_proj_b,
            'w_mix_out': w_mix_out, 'ln1_g': ln1_g, 'ln1_b': ln1_b,
            'w_xq': w_xq, 'w_xk': w_xk, 'w_xv': w_xv, 'w_xo': w_xo, 'ln2_g': ln2_g, 'ln2_b': ln2_b,
            'w_ffn_gate': w_ffn_gate, 'w_ffn_up': w_ffn_up, 'w_ffn_down': w_ffn_down,
            'ln3_g': ln3_g, 'ln3_b': ln3_b}


def reference(x, mem, positions, w_in, b_in, conv_w, conv_b, ml_norm_w, lam_q1, lam_k1, lam_q2,
              lam_k2, da_norm_w, w_proj_a, w_proj_b, w_mix_out, ln1_g, ln1_b, w_xq, w_xk, w_xv,
              w_xo, ln2_g, ln2_b, w_ffn_gate, w_ffn_up, w_ffn_down, ln3_g, ln3_b):
    B, S, D = x.shape
    M = mem.shape[1]
    offsets = [int(o) for o in np.cumsum(IN_SIZES)[:-1]]
    for l in range(DEPTH):
        proj = jnp.einsum('bsd,de->bse', x, w_in[l]) + b_in[l]
        ml_qk, ml_v, ml_o, ml_if, da_q, da_k, da_v, gates = jnp.split(proj, offsets, axis=-1)

        qk = jax.nn.silu(causal_dwconv(ml_qk, conv_w[l], conv_b[l]))
        mq, mk = jnp.split(qk, 2, axis=-1)
        h = mlstm_chunkwise(mq.reshape(B, S, ML_HEADS, ML_DQK), mk.reshape(B, S, ML_HEADS, ML_DQK),
                            ml_v.reshape(B, S, ML_HEADS, ML_DV),
                            ml_if[..., :ML_HEADS], ml_if[..., ML_HEADS:])
        h = head_layer_norm(h, ml_norm_w[l].reshape(ML_HEADS, ML_DV)).reshape(B, S, ML_V_W)
        y_a = (jax.nn.sigmoid(ml_o) * h).astype(x.dtype) @ w_proj_a[l]

        dq = rope(da_q.reshape(B, S, DA_HEADS * 2, DA_DHEAD), positions).reshape(B, S, DA_HEADS, 2, DA_DHEAD)
        dk = rope(da_k.reshape(B, S, DA_HEADS * 2, DA_DHEAD), positions).reshape(B, S, DA_HEADS, 2, DA_DHEAD)
        dvv = da_v.reshape(B, S, DA_HEADS, DA_DV)
        lam_init = 0.8 - 0.6 * math.exp(-0.3 * l)
        lam = (jnp.exp(jnp.sum(lam_q1[l] * lam_k1[l]).astype(jnp.float32))
               - jnp.exp(jnp.sum(lam_q2[l] * lam_k2[l]).astype(jnp.float32)) + lam_init)
        o = diff_attention(dq, dk, dvv, lam)
        o = head_rms_norm(o, da_norm_w[l].reshape(DA_HEADS, DA_DV)) * (1.0 - lam_init)
        y_b = o.reshape(B, S, DA_V_W).astype(x.dtype) @ w_proj_b[l]

        g_a, g_b = jnp.split(jax.nn.sigmoid(gates), 2, axis=-1)
        mix = (g_a * y_a + g_b * y_b) @ w_mix_out[l]
        x = layer_norm(ALPHA * x + mix, ln1_g[l], ln1_b[l])

        xq = (x @ w_xq[l]).reshape(B, S, XA_HEADS, XA_DHEAD)
        xk = (mem @ w_xk[l]).reshape(B, M, XA_HEADS, XA_DHEAD)
        xv = (mem @ w_xv[l]).reshape(B, M, XA_HEADS, XA_DHEAD)
        s = jnp.einsum('bqhd,bkhd->bhqk', xq, xk).astype(jnp.float32) * (XA_DHEAD ** -0.5)
        p = jax.nn.softmax(s, axis=-1)
        xo = jnp.einsum('bhqk,bkhd->bqhd', p.astype(xv.dtype), xv).reshape(B, S, XA_HEADS * XA_DHEAD)
        x = layer_norm(ALPHA * x + xo @ w_xo[l], ln2_g[l], ln2_b[l])

        hid = jax.nn.silu(x @ w_ffn_gate[l]) * (x @ w_ffn_up[l])
        x = layer_norm(ALPHA * x + hid @ w_ffn_down[l], ln3_g[l], ln3_b[l])
    return x
```

```cpp
#include <hip/hip_runtime.h>
#include <hip/hip_cooperative_groups.h>
#include <cstdio>
#include <cstdint>
namespace cg = cooperative_groups;
namespace pg8 {
#define PG8_LAS __attribute__((address_space(3)))
typedef unsigned short bf16_t;
typedef short bf16x8 __attribute__((ext_vector_type(8)));
typedef float f32x4 __attribute__((ext_vector_type(4)));
typedef unsigned u32x4 __attribute__((ext_vector_type(4)));
constexpr int BM = 256, BK = 64, HALF = 128, HTB = HALF * BK * 2  , STAGE_BYTES = 8 * HTB, NXCD = 8, WGM = 8;

__host__ __device__ __forceinline__ int lds_byte(int r, int c) { const int st = (r >> 4) * 2 + (c >> 5), rr = r & 15, cc = c & 31, ob = rr * 64 + cc * 2; return st * 1024 + (ob ^ (((ob >> 9) & 1) << 5)); }
__host__ __device__ __forceinline__ void stage_rc(int b, int& R, int& C) { const int st = b / 1024, sb = b % 1024, swz = sb ^ (((sb >> 9) & 1) << 5); R = (st >> 1) * 16 + swz / 64; C = (st & 1) * 32 + (swz % 64) / 2; }
__host__ __device__ __forceinline__ int perm32(int rho) { const int n = rho >> 4, i = rho & 15; return 8 * (i >> 2) + 4 * n + (i & 3); }

struct Unit { int pm, pn; };
struct Gemm { const bf16_t* A; const bf16_t* Bt; int M, N, K; };

struct StaticOrder {
    int nM, nN, nwg, G, c;
    __host__ __device__ void init(int M, int N, int G_, int c_) { nM = M / BM; nN = N / BM; nwg = nM * nN; G = G_; c = c_; }
    __host__ __device__ bool next(int i, Unit& u) const {
        const long L = (long)i * G + c; if (L >= nwg) return false;
        int wgid = (int)L; { const int q = nwg / NXCD, r = nwg % NXCD, xcd = wgid % NXCD, off = wgid / NXCD; wgid = (xcd < r ? xcd * (q + 1) : r * (q + 1) + (xcd - r) * q) + off; }
        const int nig = WGM * nN, gid = wgid / nig, fm = gid * WGM, gsz = (nM - fm) < WGM ? (nM - fm) : WGM;
        u.pm = fm + ((wgid % nig) % gsz); u.pn = (wgid % nig) / gsz; return true;
    }
    __device__ __forceinline__ void a_ready(const Unit&) const {}
    __device__ __forceinline__ void done(const Unit&) const {}
};

__device__ __forceinline__ unsigned cvt_pk_bf16(float lo, float hi) { unsigned r; asm volatile("s_nop 1\n\tv_cvt_pk_bf16_f32 %0, %1, %2" : "=v"(r) : "v"(lo), "v"(hi)); return r; }
typedef float f32x2 __attribute__((ext_vector_type(2)));
typedef unsigned u32x2 __attribute__((ext_vector_type(2)));
__device__ __forceinline__ float fsigmoid(float x) { return __builtin_amdgcn_rcpf(1.0f + __builtin_amdgcn_exp2f(-1.4426950408889634f * x)); }
__device__ __forceinline__ float bflo(unsigned w) { return __uint_as_float(w << 16); }
__device__ __forceinline__ float bfhi(unsigned w) { return __uint_as_float(w & 0xffff0000u); }
__device__ __forceinline__ u32x4 pack8(const f32x4 v0, const f32x4 v1) { u32x4 w; w.x = cvt_pk_bf16(v0[0], v0[1]); w.y = cvt_pk_bf16(v0[2], v0[3]); w.z = cvt_pk_bf16(v1[0], v1[1]); w.w = cvt_pk_bf16(v1[2], v1[3]); return w; }

template <int ACT  > struct EpiPlain {
    static constexpr bool PERM = true, AFTER_DRAIN = false;
    bf16_t* O; int ldc; const float* bias; float scale;
    __device__ __forceinline__ void operator()(const f32x4 (&acc)[2][2][4][2], const Unit& u, int wr, int wc, int fr, int fq) const {
        const int row0 = u.pm * BM + wr * 64 + fr, col0 = u.pn * BM + wc * 32 + 8 * fq;
        f32x4 bv[2][2];
#pragma unroll
        for (int bj = 0; bj < 2; ++bj)
#pragma unroll
            for (int n = 0; n < 2; ++n) bv[bj][n] = bias ? *(const f32x4*)(bias + col0 + bj * HALF + 4 * n) : (f32x4){0.f, 0.f, 0.f, 0.f};
#pragma unroll
        for (int ai = 0; ai < 2; ++ai)
#pragma unroll
            for (int m = 0; m < 4; ++m) { bf16_t* rowp = O + (size_t)(row0 + ai * HALF + m * 16) * ldc + col0;
#pragma unroll
                for (int bj = 0; bj < 2; ++bj) { f32x4 v0 = (acc[ai][bj][m][0] + bv[bj][0]) * scale, v1 = (acc[ai][bj][m][1] + bv[bj][1]) * scale;
                    if (ACT == 1) {
#pragma unroll
                        for (int e = 0; e < 4; ++e) { v0[e] = fsigmoid(v0[e]); v1[e] = fsigmoid(v1[e]); } }
                    *(u32x4*)(rowp + bj * HALF) = pack8(v0, v1); } }
    }
};

struct EpiIn1 {
    static constexpr bool PERM = true, AFTER_DRAIN = false;
    bf16_t *QKRAW, *MLV, *DQ, *DK, *DV; const float* bin; const float *COS, *SIN; float qscale;
    __device__ __forceinline__ void operator()(const f32x4 (&acc)[2][2][4][2], const Unit& u, int wr, int wc, int fr, int fq) const {
        const int pn = u.pn, row0 = u.pm * BM + wr * 64 + fr;
        if (pn < 8 || pn >= 16) {
            bf16_t* base; int cb, bb;
            if (pn < 4) { base = QKRAW; cb = pn * 256; bb = pn * 256; }
            else if (pn < 8) { base = MLV; cb = (pn - 4) * 256; bb = 1024 + (pn - 4) * 256; }
            else { base = DV; cb = (pn - 16) * 256; bb = 5128 + (pn - 16) * 256; }
            const int col0 = cb + wc * 32 + 8 * fq; const float* bp = bin + bb + wc * 32 + 8 * fq;
            f32x4 bv[2][2];
#pragma unroll
            for (int bj = 0; bj < 2; ++bj)
#pragma unroll
                for (int n = 0; n < 2; ++n) bv[bj][n] = *(const f32x4*)(bp + bj * HALF + 4 * n);
#pragma unroll
            for (int ai = 0; ai < 2; ++ai)
#pragma unroll
                for (int m = 0; m < 4; ++m) { bf16_t* rowp = base + (size_t)(row0 + ai * HALF + m * 16) * 1024 + col0;
#pragma unroll
                    for (int bj = 0; bj < 2; ++bj) *(u32x4*)(rowp + bj * HALF) = pack8(acc[ai][bj][m][0] + bv[bj][0], acc[ai][bj][m][1] + bv[bj][1]); }
        } else {
            const bool isq = pn < 12; bf16_t* base = isq ? DQ : DK; const int t4 = isq ? pn - 8 : pn - 12;
            const float sc = isq ? qscale : 1.0f;
            const int lc = t4 * 256 + wc * 64 + 8 * fq;
            const float* bp = bin + (isq ? 3080 : 4104) + lc;
            f32x4 bl[2], bh[2];
#pragma unroll
            for (int n = 0; n < 2; ++n) { bl[n] = *(const f32x4*)(bp + 4 * n); bh[n] = *(const f32x4*)(bp + 32 + 4 * n); }
#pragma unroll
            for (int ai = 0; ai < 2; ++ai)
#pragma unroll
                for (int m = 0; m < 4; ++m) { const size_t row = (size_t)(row0 + ai * HALF + m * 16);
                    f32x4 lo[2], hi[2];
#pragma unroll
                    for (int n = 0; n < 2; ++n) { const f32x4 cs = *(const f32x4*)(COS + row * 32 + 8 * fq + 4 * n), sn = *(const f32x4*)(SIN + row * 32 + 8 * fq + 4 * n);
                        const f32x4 a = acc[ai][0][m][n] + bl[n], b = acc[ai][1][m][n] + bh[n];
                        lo[n] = (a * cs - b * sn) * sc; hi[n] = (b * cs + a * sn) * sc; }
                    bf16_t* rowp = base + row * 1024 + lc;
                    *(u32x4*)(rowp) = pack8(lo[0], lo[1]); *(u32x4*)(rowp + 32) = pack8(hi[0], hi[1]); }
        }
    }
};

struct EpiIn2 {
    static constexpr bool PERM = true, AFTER_DRAIN = false;
    bf16_t *SIGO, *GATES; const float* bin;
    __device__ __forceinline__ void operator()(const f32x4 (&acc)[2][2][4][2], const Unit& u, int wr, int wc, int fr, int fq) const {
        const int pn = u.pn, row0 = u.pm * BM + wr * 64 + fr;
        bf16_t* base; int cb, bb, ldc;
        if (pn < 4) { base = SIGO; cb = pn * 256; bb = 2048 + pn * 256; ldc = 1024; }
        else { base = GATES; cb = (pn - 4) * 256; bb = 6152 + (pn - 4) * 256; ldc = 2048; }
        const int col0 = cb + wc * 32 + 8 * fq; const float* bp = bin + bb + wc * 32 + 8 * fq;
        f32x4 bv[2][2];
#pragma unroll
        for (int bj = 0; bj < 2; ++bj)
#pragma unroll
            for (int n = 0; n < 2; ++n) bv[bj][n] = *(const f32x4*)(bp + bj * HALF + 4 * n);
#pragma unroll
        for (int ai = 0; ai < 2; ++ai)
#pragma unroll
            for (int m = 0; m < 4; ++m) { bf16_t* rowp = base + (size_t)(row0 + ai * HALF + m * 16) * ldc + col0;
#pragma unroll
                for (int bj = 0; bj < 2; ++bj) { f32x4 v0 = acc[ai][bj][m][0] + bv[bj][0], v1 = acc[ai][bj][m][1] + bv[bj][1];
#pragma unroll
                    for (int e = 0; e < 4; ++e) { v0[e] = fsigmoid(v0[e]); v1[e] = fsigmoid(v1[e]); }
                    *(u32x4*)(rowp + bj * HALF) = pack8(v0, v1); } }
    }
};

template <bool SECOND> struct EpiGate {
    static constexpr bool PERM = true, AFTER_DRAIN = false;
    bf16_t* O; const bf16_t* G; const bf16_t* OIN;
    __device__ __forceinline__ void operator()(const f32x4 (&acc)[2][2][4][2], const Unit& u, int wr, int wc, int fr, int fq) const {
        const int row0 = u.pm * BM + wr * 64 + fr, col0 = u.pn * BM + wc * 32 + 8 * fq;
#pragma unroll
        for (int ai = 0; ai < 2; ++ai)
#pragma unroll
            for (int m = 0; m < 4; ++m) { const size_t row = (size_t)(row0 + ai * HALF + m * 16);
#pragma unroll
                for (int bj = 0; bj < 2; ++bj) { const int c = col0 + bj * HALF;
#if defined(DIAG) && DIAG == 8
                    const u32x4 g = (u32x4){0x3f003f00u, 0x3f003f00u, 0x3f003f00u, 0x3f003f00u};
#else
                    const u32x4 g = *(const u32x4*)(G + row * 2048 + (SECOND ? 1024 : 0) + c);
#endif
                    f32x4 v0 = acc[ai][bj][m][0], v1 = acc[ai][bj][m][1];
                    v0[0] *= bflo(g.x); v0[1] *= bfhi(g.x); v0[2] *= bflo(g.y); v0[3] *= bfhi(g.y);
                    v1[0] *= bflo(g.z); v1[1] *= bfhi(g.z); v1[2] *= bflo(g.w); v1[3] *= bfhi(g.w);
                    if (SECOND) { const u32x4 o = *(const u32x4*)(OIN + row * 1024 + c);
                        v0[0] += bflo(o.x); v0[1] += bfhi(o.x); v0[2] += bflo(o.y); v0[3] += bfhi(o.y);
                        v1[0] += bflo(o.z); v1[1] += bfhi(o.z); v1[2] += bflo(o.w); v1[3] += bfhi(o.w); }
                    *(u32x4*)(O + row * 1024 + c) = pack8(v0, v1); } }
    }
};

struct EpiRes {
    static constexpr bool PERM = false, AFTER_DRAIN = false;
    const float* X; float* OUT; float alpha;
    __device__ __forceinline__ void operator()(const f32x4 (&acc)[2][2][4][2], const Unit& u, int wr, int wc, int fr, int fq) const {
        const int row0 = u.pm * BM + wr * 64 + fr, col0 = u.pn * BM + wc * 32 + 4 * fq;
#pragma unroll
        for (int ai = 0; ai < 2; ++ai)
#pragma unroll
            for (int m = 0; m < 4; ++m) { const size_t off = (size_t)(row0 + ai * HALF + m * 16) * 1024 + col0;
#pragma unroll
                for (int bj = 0; bj < 2; ++bj)
#pragma unroll
                    for (int n = 0; n < 2; ++n) { const f32x4 xv = *(const f32x4*)(X + off + bj * HALF + n * 16);
                        *(f32x4*)(OUT + off + bj * HALF + n * 16) = xv * alpha + acc[ai][bj][m][n]; } }
    }
};

struct EpiSwiglu {
    static constexpr bool PERM = true, AFTER_DRAIN = false;
    bf16_t* HID; int ldc;
    __device__ __forceinline__ void operator()(const f32x4 (&acc)[2][2][4][2], const Unit& u, int wr, int wc, int fr, int fq) const {
        const int row0 = u.pm * BM + wr * 64 + fr, col0 = u.pn * HALF + wc * 32 + 8 * fq;
#pragma unroll
        for (int ai = 0; ai < 2; ++ai)
#pragma unroll
            for (int m = 0; m < 4; ++m) { f32x4 v[2];
#pragma unroll
                for (int n = 0; n < 2; ++n) { const f32x4 g = acc[ai][0][m][n], up = acc[ai][1][m][n];
#pragma unroll
                    for (int e = 0; e < 4; ++e) v[n][e] = g[e] * fsigmoid(g[e]) * up[e]; }
                *(u32x4*)(HID + (size_t)(row0 + ai * HALF + m * 16) * ldc + col0) = pack8(v[0], v[1]); }
    }
};
template <class Epi, class Sched, bool ALIGN_EPI = false, bool SP2 = false>
__device__ __forceinline__ void gemm_phase(PG8_LAS unsigned char* lds, const Gemm g, const Sched& S, const Epi& E) {
    int tid_ = threadIdx.x; asm volatile("" : "+v"(tid_));
    const int tid = tid_, wid = __builtin_amdgcn_readfirstlane(tid >> 6), lane = tid & 63, wr = wid >> 2, wc = wid & 3, fr = lane & 15, fq = lane >> 4;
    const int K = g.K, nt = K / BK;
    unsigned voffA[2], voffB[2];
#pragma unroll
    for (int i = 0; i < 2; ++i) { int R, C; stage_rc(tid * 16 + i * 8192, R, C); const int Rb = Epi::PERM ? ((R & ~31) + perm32(R & 31)) : R;
        voffA[i] = (unsigned)(R * K + C) * 2u; voffB[i] = (unsigned)(Rb * K + C) * 2u; }
    const size_t kstep = (size_t)(BK * 2);
    const size_t hstep = (size_t)HALF * K * 2;
    const size_t tstep = 2 * hstep;
    const unsigned ldsw = (unsigned)wid * 1024u;
    const int aoff = lds_byte(wr * 64 + fr, fq * 8), boff = lds_byte(wc * 32 + fr, fq * 8);
#define PG8_SA(b, h) (((b) * 2 + (h)) * HTB)
#define PG8_SB(b, h) ((4 + (b) * 2 + (h)) * HTB)
#define PG8_STAGE(bufoff, gbase, voff) do { _Pragma("unroll") for (int _i = 0; _i < 2; ++_i) \
        __builtin_amdgcn_global_load_lds((const unsigned*)((const char*)(gbase) + (voff)[_i]), (PG8_LAS unsigned*)(lds + (bufoff) + ldsw + _i * 8192), 16, 0, 0); } while (0)
#define PG8_LDA(dst, b, h) do { _Pragma("unroll") for (int m = 0; m < 4; ++m) _Pragma("unroll") for (int k = 0; k < 2; ++k) dst[m][k] = *(const PG8_LAS bf16x8*)(lds + PG8_SA(b, h) + aoff + m * 2048 + k * 1024); } while (0)
#define PG8_LDB(dst, b, h) do { _Pragma("unroll") for (int n = 0; n < 2; ++n) _Pragma("unroll") for (int k = 0; k < 2; ++k) dst[n][k] = *(const PG8_LAS bf16x8*)(lds + PG8_SB(b, h) + boff + n * 2048 + k * 1024); } while (0)
#define PG8_MMA(ai, bj, At, Bt) do { __builtin_amdgcn_s_setprio(1); _Pragma("unroll") for (int m = 0; m < 4; ++m) _Pragma("unroll") for (int n = 0; n < 2; ++n) _Pragma("unroll") for (int k = 0; k < 2; ++k) \
        acc[ai][bj][m][n] = __builtin_amdgcn_mfma_f32_16x16x32_bf16(Bt[n][k], At[m][k], acc[ai][bj][m][n], 0, 0, 0); __builtin_amdgcn_s_setprio(0); } while (0)
#define PG8_WAIT_V(n) asm volatile("s_waitcnt vmcnt(" #n ")" ::: "memory")
#define PG8_WAIT_L(n) asm volatile("s_waitcnt lgkmcnt(" #n ")" ::: "memory")
#define PG8_BAR __builtin_amdgcn_s_barrier()
#define PG8_SCHED __builtin_amdgcn_sched_barrier(0)
    Unit cur, nxt; int ui = 0;
    if (!S.next(0, cur)) return;
    f32x4 acc[2][2][4][2];
#pragma unroll
    for (int a = 0; a < 2; ++a)
#pragma unroll
        for (int b = 0; b < 2; ++b)
#pragma unroll
            for (int m = 0; m < 4; ++m)
#pragma unroll
                for (int n = 0; n < 2; ++n) acc[a][b][m][n] = (f32x4){0.f, 0.f, 0.f, 0.f};
    bf16x8 At[4][2], B0[2][2], B1[2][2];
    const char* cA = (const char*)g.A + (size_t)cur.pm * tstep; const char* cB = (const char*)g.Bt + (size_t)cur.pn * tstep;
    S.a_ready(cur);
    if constexpr (SP2) {
        PG8_STAGE(PG8_SB(0, 0), cB, voffB); PG8_STAGE(PG8_SB(0, 1), cB + hstep, voffB); PG8_STAGE(PG8_SA(0, 0), cA, voffA); PG8_STAGE(PG8_SA(0, 1), cA + hstep, voffA);
        if (wr == 1) PG8_BAR;
        PG8_WAIT_V(2); PG8_BAR;
        PG8_STAGE(PG8_SB(1, 0), cB + kstep, voffB); PG8_STAGE(PG8_SA(1, 0), cA + kstep, voffA); PG8_STAGE(PG8_SB(1, 1), cB + hstep + kstep, voffB);
        PG8_WAIT_V(6); PG8_BAR;
    } else {
        PG8_STAGE(PG8_SB(0, 0), cB, voffB); PG8_STAGE(PG8_SA(0, 0), cA, voffA); PG8_STAGE(PG8_SB(0, 1), cB + hstep, voffB); PG8_STAGE(PG8_SA(0, 1), cA + hstep, voffA);
        if (wr == 1) PG8_BAR;
        PG8_WAIT_V(4); PG8_BAR;
        PG8_STAGE(PG8_SB(1, 0), cB + kstep, voffB); PG8_STAGE(PG8_SA(1, 0), cA + kstep, voffA); PG8_STAGE(PG8_SB(1, 1), cB + hstep + kstep, voffB);
        PG8_WAIT_V(6); PG8_BAR;
    }
    for (;;) {
        const bool has_next = S.next(ui + 1, nxt);
        const char* nA = has_next ? (const char*)g.A + (size_t)nxt.pm * tstep : cA; const char* nB = has_next ? (const char*)g.Bt + (size_t)nxt.pn * tstep : cB;
        for (int t = 0; t < nt; t += 2) {
            const bool last = (t == nt - 2);
            const char* a1 = cA + (size_t)(t + 1) * kstep;
            const char* a2 = last ? nA : cA + (size_t)(t + 2) * kstep; const char* b2 = last ? nB : cB + (size_t)(t + 2) * kstep;
            const char* a3 = a2 + kstep; const char* b3 = b2 + kstep;
            if (last && has_next) S.a_ready(nxt);
            if constexpr (SP2) {
            PG8_LDB(B0, 0, 0); PG8_LDB(B1, 0, 1); PG8_SCHED; PG8_LDA(At, 0, 0); PG8_STAGE(PG8_SA(1, 1), a1 + hstep, voffA);
            PG8_WAIT_V(8); PG8_WAIT_L(0); PG8_BAR; PG8_MMA(0, 0, At, B0); PG8_MMA(0, 1, At, B1); PG8_BAR; PG8_SCHED;
            PG8_LDA(At, 0, 1); PG8_STAGE(PG8_SB(0, 0), b2, voffB); PG8_STAGE(PG8_SB(0, 1), b2 + hstep, voffB); PG8_STAGE(PG8_SA(0, 0), a2, voffA);
            PG8_WAIT_V(8); PG8_WAIT_L(0); PG8_BAR; PG8_MMA(1, 0, At, B0); PG8_MMA(1, 1, At, B1); PG8_BAR; PG8_SCHED;
            PG8_LDB(B0, 1, 0); PG8_LDB(B1, 1, 1); PG8_SCHED; PG8_LDA(At, 1, 0); PG8_STAGE(PG8_SA(0, 1), a2 + hstep, voffA);
            PG8_WAIT_V(8); PG8_WAIT_L(0); PG8_BAR; PG8_MMA(0, 0, At, B0); PG8_MMA(0, 1, At, B1); PG8_BAR; PG8_SCHED;
            PG8_LDA(At, 1, 1); PG8_STAGE(PG8_SB(1, 0), b3, voffB); PG8_STAGE(PG8_SB(1, 1), b3 + hstep, voffB); PG8_STAGE(PG8_SA(1, 0), a3, voffA);
            PG8_WAIT_V(8); PG8_WAIT_L(0); PG8_BAR; PG8_MMA(1, 0, At, B0); PG8_MMA(1, 1, At, B1); PG8_BAR; PG8_SCHED;
            } else {
            PG8_LDB(B0, 0, 0); PG8_SCHED; PG8_LDA(At, 0, 0); PG8_STAGE(PG8_SA(1, 1), a1 + hstep, voffA);
            PG8_WAIT_L(8); PG8_BAR; PG8_WAIT_L(0); PG8_MMA(0, 0, At, B0); PG8_BAR; PG8_SCHED;
            PG8_LDB(B1, 0, 1); PG8_STAGE(PG8_SB(0, 0), b2, voffB);
            PG8_BAR; PG8_WAIT_L(0); PG8_MMA(0, 1, At, B1); PG8_BAR;
            PG8_LDA(At, 0, 1); PG8_STAGE(PG8_SA(0, 0), a2, voffA);
            PG8_BAR; PG8_WAIT_L(0); PG8_MMA(1, 0, At, B0); PG8_BAR; PG8_SCHED;
            PG8_STAGE(PG8_SB(0, 1), b2 + hstep, voffB);
            PG8_WAIT_V(6); PG8_BAR; PG8_MMA(1, 1, At, B1); PG8_BAR;
            PG8_LDB(B0, 1, 0); PG8_SCHED; PG8_LDA(At, 1, 0); PG8_STAGE(PG8_SA(0, 1), a2 + hstep, voffA);
            PG8_WAIT_L(8); PG8_BAR; PG8_WAIT_L(0); PG8_MMA(0, 0, At, B0); PG8_BAR; PG8_SCHED;
            PG8_LDB(B1, 1, 1); PG8_STAGE(PG8_SB(1, 0), b3, voffB);
            PG8_BAR; PG8_WAIT_L(0); PG8_MMA(0, 1, At, B1); PG8_BAR;
            PG8_LDA(At, 1, 1); PG8_STAGE(PG8_SA(1, 0), a3, voffA);
            PG8_BAR; PG8_WAIT_L(0); PG8_MMA(1, 0, At, B0); PG8_BAR; PG8_SCHED;
            PG8_STAGE(PG8_SB(1, 1), b3 + hstep, voffB);
            PG8_WAIT_V(6); PG8_BAR; PG8_MMA(1, 1, At, B1); PG8_BAR;
            }
        }
        if constexpr (ALIGN_EPI) { if (wr == 0) PG8_BAR; }
        if constexpr (!Epi::AFTER_DRAIN) { E(acc, cur, wr, wc, fr, fq); S.done(cur); }
        if (!has_next) break;
#pragma unroll
        for (int a = 0; a < 2; ++a)
#pragma unroll
            for (int b = 0; b < 2; ++b)
#pragma unroll
                for (int m = 0; m < 4; ++m)
#pragma unroll
                    for (int n = 0; n < 2; ++n) acc[a][b][m][n] = (f32x4){0.f, 0.f, 0.f, 0.f};
        cur = nxt; cA = nA; cB = nB; ++ui;
        if constexpr (ALIGN_EPI) { if (wr == 1) PG8_BAR; }
    }
    PG8_WAIT_V(0);
    if constexpr (!ALIGN_EPI) { if (wr == 0) PG8_BAR; }
    PG8_BAR;
    if constexpr (Epi::AFTER_DRAIN) { E.fused(acc, cur, wr, wc, fr, fq, lds, wid, lane); S.done(cur); }
#undef PG8_SA
#undef PG8_SB
#undef PG8_STAGE
#undef PG8_LDA
#undef PG8_LDB
#undef PG8_MMA
#undef PG8_WAIT_V
#undef PG8_WAIT_L
#undef PG8_BAR
#undef PG8_SCHED
}
}
#define PG8_SP2 true
#include <hip/hip_bf16.h>
#include <cmath>
namespace attn_body {
using bf16=__hip_bfloat16;
using bf16x8=__attribute__((ext_vector_type(8)))short;
using s16x4=__attribute__((ext_vector_type(4)))short;
using f32x16=__attribute__((ext_vector_type(16)))float;
using u32x4=__attribute__((ext_vector_type(4)))unsigned;
constexpr int BATCH=16,NHEAD=16,SEQ=2048,D=64,DM=1024;
constexpr int NW=8,QBLK=32,QB=QBLK*NW,KVBLK=64,NQB=SEQ/QB;
constexpr int ATTN_PITCH=DM, ATTN_UNIT_ROWS=QB;
__device__ __forceinline__ int crow(int r,int hi){return (r&3)+8*(r>>2)+4*hi;}
#define SBAR() __builtin_amdgcn_sched_barrier(0)
__device__ __forceinline__ void cmask(f32x16&p0,f32x16&p1,int jb,int qrel,int hi){
  const float NEG=-INFINITY; int kb=64*jb+4*hi;
  #pragma unroll
  for(int r=0;r<16;++r){int kv=kb+(r&3)+8*(r>>2); if(kv>qrel)p0[r]=NEG; if(kv+32>qrel)p1[r]=NEG;}
}

constexpr int NSLOT=3, SLOTB=8192;
constexpr int LDS_K=0, LDS_V=NSLOT*SLOTB, LDS_WS=2*NSLOT*SLOTB, LDS_OST=LDS_WS+NW*64*4, LDS_BYTES=LDS_OST+NW*4096;
constexpr float C2=0.125f*1.4426950408889634f;
__device__ __forceinline__ void glds16(const void*gsrc,unsigned lds_dst){unsigned keep;
  asm volatile("s_mov_b32 %0, m0\n\ts_mov_b32 m0, %2\n\ts_nop 0\n\tglobal_load_lds_dwordx4 %1, off\n\ts_mov_b32 m0, %0":"=&s"(keep):"v"(gsrc),"s"(lds_dst):"memory");}
__device__ __forceinline__ float max3f(float a,float b,float c){float r;asm("v_max3_f32 %0, %1, %2, %3":"=v"(r):"v"(a),"v"(b),"v"(c));return r;}
__device__ __forceinline__ float max2f(float a,float b){float r;asm("v_max_f32_e32 %0, %1, %2":"=v"(r):"v"(a),"v"(b));return r;}
__device__ __forceinline__ float fadd_s(float a,float b){float r;asm("v_add_f32_e32 %0, %1, %2":"=v"(r):"v"(a),"v"(b));return r;}
__device__ __forceinline__ float fsub_s(float a,float b){float r;asm("v_sub_f32_e32 %0, %1, %2":"=v"(r):"v"(a),"v"(b));return r;}
typedef float f32x2_t __attribute__((ext_vector_type(2))); typedef __bf16 bf16x2_t __attribute__((ext_vector_type(2)));
__device__ __forceinline__ unsigned cvtpk_s(float lo,float hi){f32x2_t v={lo,hi};bf16x2_t b=__builtin_convertvector(v,bf16x2_t);return __builtin_bit_cast(unsigned,b);}
#define WAIT_BAR(N) asm volatile("s_waitcnt vmcnt(" #N ") lgkmcnt(0)\n\ts_barrier":::"memory")

__device__ __forceinline__ void qkt(f32x16&p0,f32x16&p1,const char*Kslot,const bf16x8*qr,const f32x16&negm,int r32,int hi){
  const char*kb=Kslot+hi*1024+r32*16;
  #pragma unroll
  for(int d0=0;d0<4;++d0){
    const bf16x8 b0=*reinterpret_cast<const bf16x8*>(kb+d0*2048);
    const bf16x8 b1=*reinterpret_cast<const bf16x8*>(kb+d0*2048+512);
    if(d0==0){p0=__builtin_amdgcn_mfma_f32_32x32x16_bf16(b0,qr[0],negm,0,0,0);p1=__builtin_amdgcn_mfma_f32_32x32x16_bf16(b1,qr[0],negm,0,0,0);}
    else{p0=__builtin_amdgcn_mfma_f32_32x32x16_bf16(b0,qr[d0],p0,0,0,0);p1=__builtin_amdgcn_mfma_f32_32x32x16_bf16(b1,qr[d0],p1,0,0,0);}}
}
typedef __attribute__((address_space(3))) const char* lds_cptr;
typedef short v4i16_t __attribute__((ext_vector_type(4)));
__device__ __forceinline__ void kload8(bf16x8*kf,lds_cptr kp){
  kf[0]=*(const __attribute__((address_space(3))) bf16x8*)(kp);      kf[1]=*(const __attribute__((address_space(3))) bf16x8*)(kp+512);
  kf[2]=*(const __attribute__((address_space(3))) bf16x8*)(kp+2048); kf[3]=*(const __attribute__((address_space(3))) bf16x8*)(kp+2560);
  kf[4]=*(const __attribute__((address_space(3))) bf16x8*)(kp+4096); kf[5]=*(const __attribute__((address_space(3))) bf16x8*)(kp+4608);
  kf[6]=*(const __attribute__((address_space(3))) bf16x8*)(kp+6144); kf[7]=*(const __attribute__((address_space(3))) bf16x8*)(kp+6656);
}
__device__ __forceinline__ void kload2(bf16x8*kf,lds_cptr kp,int j){ kf[2*j]=*(const __attribute__((address_space(3))) bf16x8*)(kp+j*2048); kf[2*j+1]=*(const __attribute__((address_space(3))) bf16x8*)(kp+j*2048+512); }
__device__ __forceinline__ s16x4 vtr(lds_cptr p){ return __builtin_bit_cast(s16x4,__builtin_amdgcn_ds_read_tr16_b64_v4i16((__attribute__((address_space(3))) v4i16_t*)p)); }
__device__ __forceinline__ float rowmax(const f32x16&p0,const f32x16&p1){
  float a=max3f(p0[0],p0[1],p1[0]),b=max3f(p0[2],p0[3],p1[1]);a=max3f(a,p1[2],p1[3]);
  #pragma unroll
  for(int r=4;r<16;r+=4){a=max3f(a,p0[r],p0[r+1]);b=max3f(b,p0[r+2],p0[r+3]);a=max3f(a,p1[r],p1[r+1]);b=max3f(b,p1[r+2],p1[r+3]);}
  const float m=max2f(a,b);
  auto rr=__builtin_amdgcn_permlane32_swap(__float_as_uint(m),__float_as_uint(m),false,false);
  return max2f(__uint_as_float(rr[0]),__uint_as_float(rr[1]));
}
__device__ __forceinline__ void pv(f32x16*o,int vb,bf16x8 pa0,bf16x8 pa1,bf16x8 pa2,bf16x8 pa3){
  #pragma unroll
  for(int d0=0;d0<2;++d0){s16x4 lo[4],hi[4];
    #pragma unroll
    for(int ks=0;ks<4;++ks){
      asm volatile("ds_read_b64_tr_b16 %0,%1 offset:%c2":"=&v"(lo[ks]):"v"(vb),"i"(d0*4096+ks*1024):"memory");
      asm volatile("ds_read_b64_tr_b16 %0,%1 offset:%c2":"=&v"(hi[ks]):"v"(vb),"i"(d0*4096+ks*1024+512):"memory");}
    asm volatile("s_waitcnt lgkmcnt(0)":::"memory");SBAR();
    #define PK(k) (bf16x8){lo[k][0],lo[k][1],lo[k][2],lo[k][3],hi[k][0],hi[k][1],hi[k][2],hi[k][3]}
    o[d0]=__builtin_amdgcn_mfma_f32_32x32x16_bf16(pa0,PK(0),o[d0],0,0,0);
    o[d0]=__builtin_amdgcn_mfma_f32_32x32x16_bf16(pa1,PK(1),o[d0],0,0,0);
    o[d0]=__builtin_amdgcn_mfma_f32_32x32x16_bf16(pa2,PK(2),o[d0],0,0,0);
    o[d0]=__builtin_amdgcn_mfma_f32_32x32x16_bf16(pa3,PK(3),o[d0],0,0,0);
    #undef PK
  }
}

#ifndef ATTN_STORE16
#define ATTN_STORE16(p,v) (*(u32x4*)(p)=(v))
#endif
template<int THRL> __device__ __forceinline__ void attn_unit(int b,int qcol,int vcol,int qb,const bf16*Q,const bf16*__restrict__ K,const bf16*__restrict__ V,bf16*O,char*shm,bool comb,float lam){
  int tid_=threadIdx.x; asm volatile("":"+v"(tid_)); const int tid=tid_,lane=tid&63,r32=lane&31,hi=lane>>5; const int wid=__builtin_amdgcn_readfirstlane(tid>>6);
  const long rowbase=(long)b*SEQ; const int q0=qb*QB;
  const bf16*Qw=Q+(rowbase+q0+wid*QBLK)*DM+qcol;
  const bf16*Kh=K+rowbase*DM+qcol,*Vh=V+rowbase*DM+vcol;
  const unsigned lds0=(unsigned)(uintptr_t)shm;
  float*wsf=(float*)(shm+LDS_WS)+wid*64;
  const bf16*ksrc=Kh+(long)lane*DM+wid*8;
  const bf16*vsrc=Vh+(long)(16*(wid&3)+(lane>>2))*DM+(wid>>2)*32+(lane&3)*8;
  const unsigned kdst=lds0+LDS_K+wid*1024, vdst=lds0+LDS_V+wid*1024;
  #define DMA_K(t,slot) glds16(ksrc+(long)(t)*KVBLK*DM,(unsigned)__builtin_amdgcn_readfirstlane(kdst+(slot)))
  #define DMA_V(t,slot) glds16(vsrc+(long)(t)*KVBLK*DM,(unsigned)__builtin_amdgcn_readfirstlane(vdst+(slot)))
  const int vb0=(int)(lds0+LDS_V)+((lane>>4)&1)*32+(lane&3)*8+(4*hi+((lane&15)>>2))*64;
  const char*Kbase=shm+LDS_K; bf16x8 kf[8];
  const lds_cptr shm3=(lds_cptr)shm; const lds_cptr kp0=shm3+LDS_K+hi*1024+r32*16; const lds_cptr vp0=shm3+LDS_V+((lane>>4)&1)*32+(lane&3)*8+(4*hi+((lane&15)>>2))*64;
  const int NT=(q0+QB)/KVBLK;
  DMA_K(0,0);DMA_V(0,0);DMA_K(1,SLOTB);
  bf16x8 qr[4];
  #pragma unroll
  for(int d0=0;d0<4;++d0)qr[d0]=*reinterpret_cast<const bf16x8*>(&Qw[(long)r32*DM+d0*16+hi*8]);
  float mhat=0.f,l_reg=0.f;f32x16 o[2];o[0]=f32x16{};o[1]=f32x16{};f32x16 negm=f32x16{};asm volatile("":"+v"(negm));
  const int qrel=wid*QBLK+r32;
  #define CMASK(P0,P1,t) do{int jb_=(t)-(NT-4); if(jb_>=0)cmask(P0,P1,jb_,qrel,hi);}while(0)
  bool resc=false;
  #define START(P0,P1) do{ const float rm=rowmax(P0,P1); resc=false; \
    { const float dl=rm; mhat=fadd_s(mhat,dl); \
      _Pragma("unroll") for(int r=0;r<16;++r){P0[r]=fsub_s(P0[r],dl);P1[r]=fsub_s(P1[r],dl);} \
      _Pragma("unroll") for(int r=0;r<16;++r)negm[r]=-mhat; asm volatile("":"+v"(negm)); } \
    _Pragma("unroll") for(int r=0;r<16;++r)P0[r]=__builtin_amdgcn_exp2f(P0[r]); }while(0)
  #define RESC() do{ if(resc){ asm volatile("s_waitcnt lgkmcnt(0)":::"memory"); \
      _Pragma("unroll") for(int d_=0;d_<2;++d_) _Pragma("unroll") for(int r=0;r<16;++r)o[d_][r]*=wsf[crow(r,hi)]; } }while(0)
  f32x16 pA0,pA1,pB0,pB1;
  int sl_prev=0,sl_cur=0,sl_next=SLOTB;
  #define ROT() do{sl_prev=sl_cur;sl_cur=sl_next;sl_next=(sl_next==(NSLOT-1)*SLOTB)?0:sl_next+SLOTB;}while(0)
  DMA_K(2,2*SLOTB);
  WAIT_BAR(3);
  qkt(pA0,pA1,Kbase,qr,negm,r32,hi);asm volatile("s_nop 15\n\ts_nop 7":"+v"(pA0),"+v"(pA1));CMASK(pA0,pA1,0);
  START(pA0,pA1);
  _Pragma("unroll") for(int r=0;r<16;++r)pA1[r]=__builtin_amdgcn_exp2f(pA1[r]);
  WAIT_BAR(0);
  DMA_K(3,0);DMA_V(1,SLOTB);
  ROT();
  kload8(kf,kp0+sl_cur);
  WAIT_BAR(2);
  s16x4 vlo[8],vhi[8]; u32x4 pw0,pw1,pw2,pw3;
  #define PKW(P,B) cvtpk_s(P[B],P[B+1])
  #define PAF(k) __builtin_bit_cast(bf16x8,pw##k)
  #define VFR(i) (bf16x8){vlo[i][0],vlo[i][1],vlo[i][2],vlo[i][3],vhi[i][0],vhi[i][1],vhi[i][2],vhi[i][3]}
  #define PIN(x) asm volatile("":"+v"(x))
  #define MX3(a,b,c) __builtin_fmaxf(__builtin_fmaxf((a),(b)),(c))
  #define GAPA(MF,A0,A1,A2,A3,W0,W1,PW) do{ MF; sacc+=A0; sacc+=A1; sacc+=A2; sacc+=A3; PIN(sacc); W0; W1; PIN(PW); SBAR(); }while(0)
  #define EX(v) __builtin_amdgcn_exp2f(v)
  #define GAPB(MF,X,B) do{ MF; X[B]=EX(X[B]); X[B+1]=EX(X[B+1]); X[B+2]=EX(X[B+2]); X[B+3]=EX(X[B+3]); PIN(X); SBAR(); }while(0)
  #define VRD(i) do{ vlo[i]=vtr(vp_+(((i)>>2)*4096+((i)&3)*1024)); vhi[i]=vtr(vp_+(((i)>>2)*4096+((i)&3)*1024+512)); }while(0)
  #define KRD(G,j) do{ if(G){ kload2(kf,kp0+sl_next,j); SBAR(); } }while(0)
  #define STEP(C0,C1,P0,P1,t,GK,GV,GL) do{ SBAR(); \
    const lds_cptr vp_=vp0+sl_prev; \
    VRD(0); SBAR(); float sacc=(P0[0]+P0[1]); \
    GAPA(C0=__builtin_amdgcn_mfma_f32_32x32x16_bf16(kf[0],qr[0],negm,0,0,0), P0[2],P0[3],P0[4],P0[5],     pw0[0]=PKW(P0,0), pw0[1]=PKW(P0,2), pw0); \
    VRD(4); SBAR(); GAPA(C1=__builtin_amdgcn_mfma_f32_32x32x16_bf16(kf[1],qr[0],negm,0,0,0), P0[6],P0[7],P0[8],P0[9],     pw0[2]=PKW(P0,4), pw0[3]=PKW(P0,6), pw0); \
    VRD(1); SBAR(); GAPA(C0=__builtin_amdgcn_mfma_f32_32x32x16_bf16(kf[2],qr[1],C0,0,0,0),   P0[10],P0[11],P0[12],P0[13], pw1[0]=PKW(P0,8), pw1[1]=PKW(P0,10), pw1); \
    VRD(5); SBAR(); GAPA(C1=__builtin_amdgcn_mfma_f32_32x32x16_bf16(kf[3],qr[1],C1,0,0,0),   P0[14],P0[15],P1[0],P1[1],   pw1[2]=PKW(P0,12),pw1[3]=PKW(P0,14), pw1); \
    VRD(2); SBAR(); GAPA(C0=__builtin_amdgcn_mfma_f32_32x32x16_bf16(kf[4],qr[2],C0,0,0,0),   P1[2],P1[3],P1[4],P1[5],     pw2[0]=PKW(P1,0), pw2[1]=PKW(P1,2), pw2); \
    VRD(6); SBAR(); GAPA(C1=__builtin_amdgcn_mfma_f32_32x32x16_bf16(kf[5],qr[2],C1,0,0,0),   P1[6],P1[7],P1[8],P1[9],     pw2[2]=PKW(P1,4), pw2[3]=PKW(P1,6), pw2); \
    VRD(3); SBAR(); GAPA(C0=__builtin_amdgcn_mfma_f32_32x32x16_bf16(kf[6],qr[3],C0,0,0,0),   P1[10],P1[11],P1[12],P1[13], pw3[0]=PKW(P1,8), pw3[1]=PKW(P1,10), pw3); \
    VRD(7); SBAR(); GAPA(C1=__builtin_amdgcn_mfma_f32_32x32x16_bf16(kf[7],qr[3],C1,0,0,0),   P1[14],P1[15],0.f,0.f,       pw3[2]=PKW(P1,12),pw3[3]=PKW(P1,14), pw3); \
    l_reg+=sacc; \
    if(GK){DMA_K((t)+3,sl_cur);} if(GV){DMA_V((t)+1,sl_next);} \
    CMASK(C0,C1,t); \
    { float a=MX3(C0[0],C0[1],C1[0]),b=MX3(C0[2],C0[3],C1[1]); a=MX3(a,C1[2],C1[3]); \
      _Pragma("unroll") for(int r=4;r<16;r+=4){a=MX3(a,C0[r],C0[r+1]);b=MX3(b,C0[r+2],C0[r+3]);a=MX3(a,C1[r],C1[r+1]);b=MX3(b,C1[r+2],C1[r+3]);} \
      float rm=__builtin_fmaxf(a,b); { auto rr=__builtin_amdgcn_permlane32_swap(__float_as_uint(rm),__float_as_uint(rm),false,false); rm=__builtin_fmaxf(__uint_as_float(rr[0]),__uint_as_float(rr[1])); } \
      resc=false; \
      if(__builtin_expect(__any(rm>(float)THRL),0)){ const float dl=__builtin_fmaxf(rm,0.f); mhat+=dl; \
        _Pragma("unroll") for(int r=0;r<16;++r){C0[r]-=dl;C1[r]-=dl;} \
        _Pragma("unroll") for(int r=0;r<16;++r)negm[r]=-mhat; asm volatile("":"+v"(negm)); \
        const float f=__builtin_amdgcn_exp2f(-dl); l_reg*=f; if(hi==0)wsf[r32]=f; resc=true; } } \
    SBAR(); \
    GAPB(o[0]=__builtin_amdgcn_mfma_f32_32x32x16_bf16(PAF(0),VFR(0),o[0],0,0,0), C0,0); \
    GAPB(o[1]=__builtin_amdgcn_mfma_f32_32x32x16_bf16(PAF(0),VFR(4),o[1],0,0,0), C0,4); \
    KRD(GL,0); GAPB(o[0]=__builtin_amdgcn_mfma_f32_32x32x16_bf16(PAF(1),VFR(1),o[0],0,0,0), C0,8); \
    KRD(GL,1); GAPB(o[1]=__builtin_amdgcn_mfma_f32_32x32x16_bf16(PAF(1),VFR(5),o[1],0,0,0), C0,12); \
    KRD(GL,2); GAPB(o[0]=__builtin_amdgcn_mfma_f32_32x32x16_bf16(PAF(2),VFR(2),o[0],0,0,0), C1,0); \
    KRD(GL,3); GAPB(o[1]=__builtin_amdgcn_mfma_f32_32x32x16_bf16(PAF(2),VFR(6),o[1],0,0,0), C1,4); \
    GAPB(o[0]=__builtin_amdgcn_mfma_f32_32x32x16_bf16(PAF(3),VFR(3),o[0],0,0,0), C1,8); \
    GAPB(o[1]=__builtin_amdgcn_mfma_f32_32x32x16_bf16(PAF(3),VFR(7),o[1],0,0,0), C1,12); \
    }while(0)
  int t=1;
  #undef CMASK
  #define CMASK(P0,P1,t) do{}while(0)
  for(;t+5<NT;t+=2){
    STEP(pB0,pB1,pA0,pA1,t,true,true,true);     WAIT_BAR(2); RESC(); ROT();
    STEP(pA0,pA1,pB0,pB1,t+1,true,true,true);   WAIT_BAR(2); RESC(); ROT();
  }
  #undef CMASK
  #define CMASK(P0,P1,t) do{int jb_=(t)-(NT-4); if(jb_>=0)cmask(P0,P1,jb_,qrel,hi);}while(0)
  #define ENDW(tt) do{ if((tt)+3<NT){WAIT_BAR(2);} else if((tt)+2<NT){WAIT_BAR(1);} else {WAIT_BAR(0);} }while(0)
  for(;t+1<NT;t+=2){
    STEP(pB0,pB1,pA0,pA1,t,(t+3<NT),(t+1<NT),(t+1<NT));       ENDW(t);   RESC(); ROT();
    STEP(pA0,pA1,pB0,pB1,t+1,(t+4<NT),(t+2<NT),(t+2<NT));     ENDW(t+1); RESC(); ROT();
  }
  STEP(pB0,pB1,pA0,pA1,NT-1,false,false,false); RESC();
  { float sacc=pB0[0]+pB0[1]; _Pragma("unroll") for(int r=2;r<16;++r)sacc+=pB0[r]; _Pragma("unroll") for(int r=0;r<16;++r)sacc+=pB1[r]; l_reg+=sacc;
    pw0=(u32x4){PKW(pB0,0),PKW(pB0,2),PKW(pB0,4),PKW(pB0,6)};pw1=(u32x4){PKW(pB0,8),PKW(pB0,10),PKW(pB0,12),PKW(pB0,14)};pw2=(u32x4){PKW(pB1,0),PKW(pB1,2),PKW(pB1,4),PKW(pB1,6)};pw3=(u32x4){PKW(pB1,8),PKW(pB1,10),PKW(pB1,12),PKW(pB1,14)};
    SBAR(); pv(o,vb0+sl_cur,PAF(0),PAF(1),PAF(2),PAF(3)); }
  #undef PKW
  #undef PAF
  #undef VFR
  #undef PIN
  #undef MX3
  #undef GAPA
  #undef GAPB
  #undef EX
  #undef VRD
  #undef KRD
  #undef STEP
  #undef ENDW
  {auto rr=__builtin_amdgcn_permlane32_swap(__float_as_uint(l_reg),__float_as_uint(l_reg),false,false);l_reg=__uint_as_float(rr[0])+__uint_as_float(rr[1]);}
  if(hi==0)wsf[32+r32]=l_reg;asm volatile("s_waitcnt lgkmcnt(0)":::"memory");
  float rli[16];
  #pragma unroll
  for(int r=0;r<16;++r)rli[r]=__builtin_amdgcn_rcpf(wsf[32+crow(r,hi)]);
  bf16*Ow=O+(rowbase+q0+wid*QBLK)*DM+vcol;
  { bf16*stg=(bf16*)(shm+LDS_OST)+wid*2048;
    #pragma unroll
    for(int r=0;r<16;++r){const int orow=crow(r,hi);
      #pragma unroll
      for(int d0=0;d0<2;++d0)stg[orow*64+d0*32+r32]=__float2bfloat16(o[d0][r]*rli[r]);}
    asm volatile("s_waitcnt lgkmcnt(0)":::"memory");
    #pragma unroll
    for(int i=0;i<4;++i){const int row=i*8+(lane>>3),ch=lane&7; u32x4 v=*(const u32x4*)(stg+row*64+ch*8);
      if(comb){ const u32x4 w=*(const u32x4*)(Ow+(long)row*DM+ch*8); u32x4 o_;
        #pragma unroll
        for(int e=0;e<4;++e){ const float a0=__uint_as_float(w[e]<<16),a1=__uint_as_float(w[e]&0xffff0000u),b0=__uint_as_float(v[e]<<16),b1=__uint_as_float(v[e]&0xffff0000u);
          o_[e]=cvtpk_s(a0-lam*b0,a1-lam*b1);} v=o_; }
      ATTN_STORE16(Ow+(long)row*DM+ch*8,v);} }
  asm volatile("s_waitcnt lgkmcnt(0)\n\ts_barrier":::"memory");
  #undef DMA_K
  #undef DMA_V
  #undef CMASK
  #undef START
  #undef RESC
  #undef ROT
}
constexpr int ATTN_LDS_BYTES=LDS_BYTES;
#undef SBAR
#undef WAIT_BAR
}
#define LAS __attribute__((address_space(3)))
typedef unsigned short bf16;
typedef unsigned v4u __attribute__((ext_vector_type(4)));
typedef unsigned v2u __attribute__((ext_vector_type(2)));
typedef float f32x4 __attribute__((ext_vector_type(4)));
typedef float f32x16 __attribute__((ext_vector_type(16)));
typedef short bf16x8 __attribute__((ext_vector_type(8)));
typedef short s16x4 __attribute__((ext_vector_type(4)));

constexpr int NWAVES = 8, NTHR = 512;
constexpr int BATCH = 16, SEQ = 2048, D = 1024, T = BATCH * SEQ, MEMLEN = 256, TM = BATCH * MEMLEN, FF = 2816, INDIM = 8200;
constexpr float LN_EPS = 1e-5f;
constexpr float ALPHA = 1.189207115002721f;
constexpr float LOG2E = 1.4426950408889634f;
constexpr int LDS_BYTES = 147456;

constexpr size_t MiB = 1u << 20;
constexpr size_t WS_WIN1 = 0, WS_WIN2 = 10 * MiB, WS_WSQ = 16 * MiB  , WS_WGU = 30 * MiB, WS_WDN = 41 * MiB;
constexpr size_t WS_IFG = 47 * MiB, WS_COS = 48 * MiB, WS_SIN = 52 * MiB, WS_SCT = 56 * MiB, WS_CHK = 58 * MiB, WS_MPREV = 59 * MiB;
constexpr size_t WS_MEMB = 60 * MiB, WS_XK = 68 * MiB, WS_XVT = 76 * MiB;
constexpr size_t WS_S0 = 84 * MiB, WS_S1 = 148 * MiB, WS_S2 = 212 * MiB, WS_S3 = 276 * MiB, WS_S4 = 340 * MiB, WS_S5 = 404 * MiB, WS_END = 468 * MiB;

__device__ __forceinline__ unsigned f2bf(float f) { unsigned u = __builtin_bit_cast(unsigned, f); return (u + 0x7fffu + ((u >> 16) & 1u)) >> 16; }
__device__ __forceinline__ unsigned pk2(float lo, float hi) { return pg8::cvt_pk_bf16(lo, hi); }
__device__ __forceinline__ float bflo(unsigned w) { return __uint_as_float(w << 16); }
__device__ __forceinline__ float bfhi(unsigned w) { return __uint_as_float(w & 0xffff0000u); }
__device__ __forceinline__ float wave_sum(float v) {
#pragma unroll
    for (int o = 1; o < 64; o <<= 1) v += __shfl_xor(v, o);
    return v;
}
#define LDS_WAIT() asm volatile("s_waitcnt lgkmcnt(0)" ::: "memory")

__device__ __forceinline__ void transpose_item(const float* W, int ldw, int k0, int sc0, bf16* WT, int ldt, int dr0, LAS float* scr, int lane) {
#pragma unroll 8
    for (int i = 0; i < 32; ++i) { const int kk = 2 * i + (lane >> 5); scr[kk * 33 + (lane & 31)] = W[(size_t)(k0 + kk) * ldw + sc0 + (lane & 31)]; }
    LDS_WAIT(); asm volatile("" ::: "memory");
    const int c = lane & 7;
#pragma unroll
    for (int j = 0; j < 4; ++j) { const int n = (lane >> 3) + 8 * j; const LAS float* s = scr + (8 * c) * 33 + n;
        v4u o; o.x = pk2(s[0 * 33], s[1 * 33]); o.y = pk2(s[2 * 33], s[3 * 33]); o.z = pk2(s[4 * 33], s[5 * 33]); o.w = pk2(s[6 * 33], s[7 * 33]);
        *(v4u*)(WT + (size_t)(dr0 + n) * ldt + k0 + 8 * c) = o; }
    LDS_WAIT(); asm volatile("" ::: "memory");
}

struct Ptrs {
    const float* x; const float* mem; const int* pos; const float* w_in; const float* b_in; const float* conv_w; const float* conv_b; const float* ml_norm_w;
    const float *lq1, *lk1, *lq2, *lk2; const float* da_norm_w; const float* wsq[7];
    const float *ln1g, *ln1b, *ln2g, *ln2b, *ln3g, *ln3b; const float *w_gate, *w_up, *w_down;
    float* out; unsigned char* ws;
};

__device__ __forceinline__ void p0_prologue(const Ptrs& P, LAS unsigned char* lds, int gw, int NGW, int wave, int lane, int tid) {
    unsigned char* ws = P.ws;
    LAS float* scr = (LAS float*)(lds + 32768 + wave * 8704);
    constexpr int I0 = 16 * 160, I1 = 16 * 96, I2 = 7 * 512, I3 = 16 * 176, I4 = 44 * 32, NIT = I0 + I1 + I2 + I3 + I4;
    for (int it = gw; it < NIT; it += NGW) {
        int r = it;
        if (r < I0) { const int kb = r / 160, nb = r % 160, d0 = 32 * nb; int sc0;
            if (d0 < 2048) sc0 = d0;
            else if (d0 < 4096) { const int isk = d0 >= 3072, local = d0 - (isk ? 3072 : 2048), tile = local >> 8, p = local & 255, half = p >> 7, head = (p & 127) >> 5;
                sc0 = (isk ? 4104 : 3080) + tile * 256 + head * 64 + half * 32; }
            else sc0 = 5128 + (d0 - 4096);
            transpose_item(P.w_in, INDIM, 64 * kb, sc0, (bf16*)(ws + WS_WIN1), 1024, d0, scr, lane); continue; }
        r -= I0;
        if (r < I1) { const int kb = r / 96, nb = r % 96, d0 = 32 * nb; const int sc0 = d0 < 1024 ? 2048 + d0 : 6152 + (d0 - 1024);
            transpose_item(P.w_in, INDIM, 64 * kb, sc0, (bf16*)(ws + WS_WIN2), 1024, d0, scr, lane); continue; }
        r -= I1;
        if (r < I2) { const int j = r >> 9, q = r & 511, kb = q >> 5, nb = q & 31;
            const float* src = j == 0 ? P.wsq[0] : j == 1 ? P.wsq[1] : j == 2 ? P.wsq[2] : j == 3 ? P.wsq[3] : j == 4 ? P.wsq[4] : j == 5 ? P.wsq[5] : P.wsq[6];
            transpose_item(src, 1024, 64 * kb, 32 * nb, (bf16*)(ws + WS_WSQ + (size_t)j * 2 * MiB), 1024, 32 * nb, scr, lane); continue; }
        r -= I2;
        if (r < I3) { const int kb = r / 176, nb = r % 176, d0 = 32 * nb, tile = d0 >> 8, p = d0 & 255;
            const float* src = p < 128 ? P.w_gate : P.w_up; const int sc0 = tile * 128 + (p & 127);
            transpose_item(src, FF, 64 * kb, sc0, (bf16*)(ws + WS_WGU), 1024, d0, scr, lane); continue; }
        r -= I3;
        { const int kb = r >> 5, nb = r & 31; transpose_item(P.w_down, 1024, 64 * kb, 32 * nb, (bf16*)(ws + WS_WDN), FF, 32 * nb, scr, lane); }
    }
    LAS float* wif = (LAS float*)lds;
    for (int i = tid; i < 2048; i += NTHR) { const int k = i >> 1, hf = i & 1; const f32x4 v = *(const f32x4*)(P.w_in + (size_t)k * INDIM + 3072 + 4 * hf); *(LAS f32x4*)(wif + k * 8 + 4 * hf) = v; }
    __syncthreads();
    {
        bf16* XB = (bf16*)(ws + WS_S0); float* IFG = (float*)(ws + WS_IFG);
        float bi = P.b_in[3072 + (lane & 7)];
        for (int m = gw; m < T; m += NGW) {
            const f32x4* xr = (const f32x4*)(P.x + (size_t)m * D) + lane;
            f32x4 v[4];
#pragma unroll
            for (int j = 0; j < 4; ++j) v[j] = xr[64 * j];
            unsigned long long* o8 = (unsigned long long*)(XB + (size_t)m * D) + lane;
#pragma unroll
            for (int j = 0; j < 4; ++j) o8[64 * j] = (unsigned long long)pk2(v[j].x, v[j].y) | ((unsigned long long)pk2(v[j].z, v[j].w) << 32);
            float a[8];
#pragma unroll
            for (int o = 0; o < 8; ++o) a[o] = 0.f;
#pragma unroll
            for (int j = 0; j < 4; ++j)
#pragma unroll
                for (int e = 0; e < 4; ++e) { const int k = 4 * lane + 256 * j + e; const f32x4 w0 = *(LAS f32x4*)(wif + k * 8), w1 = *(LAS f32x4*)(wif + k * 8 + 4); const float xv = v[j][e];
                    a[0] += xv * w0.x; a[1] += xv * w0.y; a[2] += xv * w0.z; a[3] += xv * w0.w; a[4] += xv * w1.x; a[5] += xv * w1.y; a[6] += xv * w1.z; a[7] += xv * w1.w; }
#pragma unroll
            for (int o = 0; o < 8; ++o) a[o] = wave_sum(a[o]);
            float r = a[0];
#pragma unroll
            for (int o = 1; o < 8; ++o) r = ((lane & 7) == o) ? a[o] : r;
            if (lane < 8) IFG[(size_t)m * 8 + lane] = r + bi;
        }
    }
    {
        bf16* MB = (bf16*)(ws + WS_MEMB); const int gt = gw * 64 + lane, NGT = NGW * 64;
        for (int i = gt; i < TM * D / 8; i += NGT) { const f32x4 a = *(const f32x4*)(P.mem + (size_t)i * 8), b = *(const f32x4*)(P.mem + (size_t)i * 8 + 4);
            v4u o; o.x = pk2(a.x, a.y); o.y = pk2(a.z, a.w); o.z = pk2(b.x, b.y); o.w = pk2(b.z, b.w); *(v4u*)(MB + (size_t)i * 8) = o; }
        float* COS = (float*)(ws + WS_COS); float* SIN = (float*)(ws + WS_SIN);
        for (int i = gt; i < T * 32; i += NGT) { const int t = i >> 5, j = i & 31;
            const float inv = (float)exp2(-(double)j * (13.287712379549449 / 32.0));
            const float ang = (float)P.pos[t] * inv;
            const double rev = (double)ang * 0.15915494309189535; const double fr = rev - floor(rev);
            const float f = (float)fr;
            COS[i] = __builtin_amdgcn_cosf(f); SIN[i] = __builtin_amdgcn_sinf(f); }
    }
}

__device__ __forceinline__ void scan_step_a(unsigned char* ws, int gw, int NGW, int lane) {
    const float* IFG = (const float*)(ws + WS_IFG); f32x4* SCT = (f32x4*)(ws + WS_SCT); float* CHK = (float*)(ws + WS_CHK);
    for (int item = gw; item < 64 * 32; item += NGW) {
        const int bh = item >> 5, c = item & 31, b = bh >> 2, h = bh & 3; const size_t t = (size_t)b * SEQ + c * 64 + lane;
        const float iv = IFG[t * 8 + h], fv = IFG[t * 8 + 4 + h];
        const float lf = fminf(fv, 0.f) - __logf(1.0f + __expf(-fabsf(fv)));
        float bc = lf;
#pragma unroll
        for (int o = 1; o < 64; o <<= 1) { const float u = __shfl_up(bc, o); if (lane >= o) bc += u; }
        const float a = iv - bc; float pm = a;
#pragma unroll
        for (int o = 1; o < 64; o <<= 1) { const float u = __shfl_up(pm, o); if (lane >= o) pm = fmaxf(pm, u); }
        SCT[(size_t)bh * SEQ + c * 64 + lane] = (f32x4){a, pm, bc, 0.f};
        if (lane == 63) { CHK[(bh * 32 + c) * 2] = bc; CHK[(bh * 32 + c) * 2 + 1] = pm; }
    }
}
__device__ __forceinline__ void scan_step_b(unsigned char* ws, int tid) {
    if (blockIdx.x == 0 && tid < 64) { const float* CHK = (const float*)(ws + WS_CHK); float* MP = (float*)(ws + WS_MPREV); float m = 0.f;
        for (int c = 0; c < 32; ++c) { MP[tid * 32 + c] = m; const float bl = CHK[(tid * 32 + c) * 2], px = CHK[(tid * 32 + c) * 2 + 1]; m = bl + fmaxf(m, px); } }
}

__device__ __forceinline__ void conv_pass(const Ptrs& P, const bf16* QKRAW, bf16* MQ, bf16* MK, int gt, int NGT) {
    for (int idx = gt; idx < T * 128; idx += NGT) {
        const int t = idx >> 7, g = idx & 127, c0 = 8 * g, s = t & (SEQ - 1);
        float acc[8];
        { const f32x4 b0 = *(const f32x4*)(P.conv_b + c0), b1 = *(const f32x4*)(P.conv_b + c0 + 4); acc[0] = b0.x; acc[1] = b0.y; acc[2] = b0.z; acc[3] = b0.w; acc[4] = b1.x; acc[5] = b1.y; acc[6] = b1.z; acc[7] = b1.w; }
#pragma unroll
        for (int j = 0; j < 4; ++j) { if (s - 3 + j >= 0) {
            const v4u xv = *(const v4u*)(QKRAW + (size_t)(t - 3 + j) * 1024 + c0);
            const f32x4 w0 = *(const f32x4*)(P.conv_w + j * 1024 + c0), w1 = *(const f32x4*)(P.conv_w + j * 1024 + c0 + 4);
            acc[0] += bflo(xv.x) * w0.x; acc[1] += bfhi(xv.x) * w0.y; acc[2] += bflo(xv.y) * w0.z; acc[3] += bfhi(xv.y) * w0.w;
            acc[4] += bflo(xv.z) * w1.x; acc[5] += bfhi(xv.z) * w1.y; acc[6] += bflo(xv.w) * w1.z; acc[7] += bfhi(xv.w) * w1.w; } }
        const float sc = c0 < 512 ? 0.08838834764831845f : 1.0f;
#pragma unroll
        for (int e = 0; e < 8; ++e) acc[e] = acc[e] * pg8::fsigmoid(acc[e]) * sc;
        v4u o; o.x = pk2(acc[0], acc[1]); o.y = pk2(acc[2], acc[3]); o.z = pk2(acc[4], acc[5]); o.w = pk2(acc[6], acc[7]);
        if (c0 < 512) *(v4u*)(MQ + (size_t)t * 512 + c0) = o; else *(v4u*)(MK + (size_t)t * 512 + c0 - 512) = o;
    }
}

constexpr int ML_QS = 0, ML_KS = 17408, ML_KT = 34816, ML_VT = 53248, ML_PS = 64768, ML_CT = 73984, ML_TB = 95744;
#define MFMA16(a, b, c) __builtin_amdgcn_mfma_f32_16x16x32_bf16((a), (b), (c), 0, 0, 0)
__device__ __forceinline__ void mlstm_item(LAS unsigned char* lds, int b, int h, int dvs, const bf16* MQ, const bf16* MK, const bf16* MLV, const f32x4* SCT, const float* CHK, const float* MPREV, bf16* HML,
                                           int tid, int wid, int lane) {
    const int fr = lane & 15, fq = lane >> 4, rb = wid & 3, half = wid >> 2, bh = b * 4 + h;
    LAS float* TA = (LAS float*)(lds + ML_TB); LAS float* TMx = TA + 64; LAS float* TE = TA + 128; LAS float* TW = TA + 192; LAS float* DEN = TA + 256;
    for (int i = tid; i < 80 * 136 / 2; i += NTHR) ((LAS unsigned*)(lds + ML_CT))[i] = 0u;
    for (int i = tid; i < 16 * 72 / 2; i += NTHR) ((LAS unsigned*)(lds + ML_VT + 64 * 144))[i] = (i < 36) ? 0x3F803F80u : 0u;
    f32x4 cacc[5];
#pragma unroll
    for (int i = 0; i < 5; ++i) cacc[i] = (f32x4){0.f, 0.f, 0.f, 0.f};
    const int srow = tid >> 3, seg = tid & 7;
    const size_t tok0 = (size_t)b * SEQ;
    const bf16* qsrc = MQ + (tok0 + srow) * 512 + h * 128 + seg * 8;
    const bf16* ksrc = MK + (tok0 + srow) * 512 + h * 128 + seg * 8;
    const bf16* vsrc = MLV + (tok0 + srow) * 1024 + h * 256 + dvs * 64 + seg * 8;
    const f32x4* sct = SCT + (size_t)bh * SEQ;
    v4u q0, q1, k0, k1, v0; f32x4 scr_, sct_; float mprev, pmx;
#define ML_PREFETCH(c) do { const size_t o_ = (size_t)(c) * 64; q0 = *(const v4u*)(qsrc + o_ * 512); q1 = *(const v4u*)(qsrc + o_ * 512 + 64); k0 = *(const v4u*)(ksrc + o_ * 512); k1 = *(const v4u*)(ksrc + o_ * 512 + 64); \
        v0 = *(const v4u*)(vsrc + o_ * 1024); scr_ = sct[o_ + srow]; sct_ = sct[o_ + (tid & 63)]; mprev = MPREV[bh * 32 + (c)]; pmx = CHK[(bh * 32 + (c)) * 2 + 1]; } while (0)
    ML_PREFETCH(0);
    for (int c = 0; c < 32; ++c) {
        const float m63 = fmaxf(mprev, pmx), decay = __expf(mprev - m63), mp = mprev;
        if (tid < 64) { const float Mt = fmaxf(mp, sct_.y); TA[tid] = sct_.x; TMx[tid] = Mt; TE[tid] = __expf(-(sct_.z + Mt)); TW[tid] = __expf(mp - Mt); }
        const float wsr = __expf(scr_.x - m63);
        *(LAS v4u*)(lds + ML_QS + srow * 272 + seg * 16) = q0; *(LAS v4u*)(lds + ML_QS + srow * 272 + 128 + seg * 16) = q1;
        *(LAS v4u*)(lds + ML_KS + srow * 272 + seg * 16) = k0; *(LAS v4u*)(lds + ML_KS + srow * 272 + 128 + seg * 16) = k1;
        {
            LAS bf16* kt = (LAS bf16*)(lds + ML_KT); LAS bf16* vt = (LAS bf16*)(lds + ML_VT);
            const unsigned kk[8] = {k0.x, k0.y, k0.z, k0.w, k1.x, k1.y, k1.z, k1.w}; const unsigned vv[4] = {v0.x, v0.y, v0.z, v0.w};
#pragma unroll
            for (int e = 0; e < 4; ++e) {
                kt[(seg * 8 + 2 * e) * 72 + srow] = (bf16)f2bf(bflo(kk[e]) * wsr); kt[(seg * 8 + 2 * e + 1) * 72 + srow] = (bf16)f2bf(bfhi(kk[e]) * wsr);
                kt[(64 + seg * 8 + 2 * e) * 72 + srow] = (bf16)f2bf(bflo(kk[4 + e]) * wsr); kt[(64 + seg * 8 + 2 * e + 1) * 72 + srow] = (bf16)f2bf(bfhi(kk[4 + e]) * wsr);
                vt[(seg * 8 + 2 * e) * 72 + srow] = (bf16)(vv[e] & 0xffffu); vt[(seg * 8 + 2 * e + 1) * 72 + srow] = (bf16)(vv[e] >> 16); }
        }
        if (c + 1 < 32) ML_PREFETCH(c + 1);
        __syncthreads();
        bf16x8 qa[4];
#pragma unroll
        for (int ks = 0; ks < 4; ++ks) qa[ks] = *(const LAS bf16x8*)(lds + ML_QS + (16 * rb + fr) * 272 + ks * 64 + fq * 16);
        float tm[4], tw[4], te[4];
#pragma unroll
        for (int j = 0; j < 4; ++j) { const int t = 16 * rb + 4 * fq + j; tm[j] = TMx[t]; tw[j] = TW[t]; te[j] = TE[t]; }
#pragma unroll
        for (int ci = 0; ci < 2; ++ci) { const int cb = 2 * half + ci; f32x4 s = (f32x4){0.f, 0.f, 0.f, 0.f};
#pragma unroll
            for (int ks = 0; ks < 4; ++ks) { const bf16x8 kf = *(const LAS bf16x8*)(lds + ML_KS + (16 * cb + fr) * 272 + ks * 64 + fq * 16); s = MFMA16(qa[ks], kf, s); }
            const int sc = 16 * cb + fr; const float as = TA[sc];
#pragma unroll
            for (int j = 0; j < 4; ++j) { const int t = 16 * rb + 4 * fq + j; const float w = (sc <= t) ? __expf(as - tm[j]) : 0.f;
                ((LAS bf16*)(lds + ML_PS))[t * 72 + sc] = (bf16)f2bf(s[j] * w); } }
        f32x4 hacc[3];
#pragma unroll
        for (int i = 0; i < 3; ++i) { hacc[i] = (f32x4){0.f, 0.f, 0.f, 0.f};
            if (i < (half ? 2 : 3)) { const int nb = half ? 3 + i : i;
#pragma unroll
                for (int ks = 0; ks < 4; ++ks) { const bf16x8 cf = *(const LAS bf16x8*)(lds + ML_CT + (16 * nb + fr) * 272 + ks * 64 + fq * 16); hacc[i] = MFMA16(qa[ks], cf, hacc[i]); }
#pragma unroll
                for (int j = 0; j < 4; ++j) hacc[i][j] *= tw[j];
#if defined(DIAG) && DIAG == 5
                hacc[i] = (f32x4){0.f, 0.f, 0.f, 0.f};
#endif
                } }
        __syncthreads();
        {
            bf16x8 pa[2];
#pragma unroll
            for (int ks = 0; ks < 2; ++ks) pa[ks] = *(const LAS bf16x8*)(lds + ML_PS + (16 * rb + fr) * 144 + ks * 64 + fq * 16);
#pragma unroll
            for (int i = 0; i < 3; ++i) if (i < (half ? 2 : 3)) { const int nb = half ? 3 + i : i;
#pragma unroll
                for (int ks = 0; ks < 2; ++ks) { const bf16x8 vf = *(const LAS bf16x8*)(lds + ML_VT + (16 * nb + fr) * 144 + ks * 64 + fq * 16); hacc[i] = MFMA16(pa[ks], vf, hacc[i]); } }
            if (half == 1 && fr == 0) {
#pragma unroll
                for (int j = 0; j < 4; ++j) DEN[16 * rb + 4 * fq + j] = hacc[1][j]; }
            bf16x8 kf[2];
#pragma unroll
            for (int ks = 0; ks < 2; ++ks) kf[ks] = *(const LAS bf16x8*)(lds + ML_KT + (16 * wid + fr) * 144 + ks * 64 + fq * 16);
#pragma unroll
            for (int nb = 0; nb < 5; ++nb) { cacc[nb] = cacc[nb] * decay;
#pragma unroll
                for (int ks = 0; ks < 2; ++ks) { const bf16x8 vf = *(const LAS bf16x8*)(lds + ML_VT + (16 * nb + fr) * 144 + ks * 64 + fq * 16); cacc[nb] = MFMA16(vf, kf[ks], cacc[nb]); }
#pragma unroll
                for (int j = 0; j < 4; ++j) ((LAS bf16*)(lds + ML_CT))[(16 * nb + 4 * fq + j) * 136 + 16 * wid + fr] = (bf16)f2bf(cacc[nb][j]); }
        }
        __syncthreads();
        {
            float rd[4];
#pragma unroll
            for (int j = 0; j < 4; ++j) rd[j] = 1.0f / fmaxf(fabsf(DEN[16 * rb + 4 * fq + j]), te[j]);
#pragma unroll
            for (int i = 0; i < 3; ++i) { const int nb = half ? 3 + i : i; if (i < (half ? 1 : 3)) {
#pragma unroll
                for (int j = 0; j < 4; ++j) HML[(tok0 + c * 64 + 16 * rb + 4 * fq + j) * 1024 + h * 256 + dvs * 64 + 16 * nb + fr] = (bf16)f2bf(hacc[i][j] * rd[j]); } }
        }
    }
    __syncthreads();
#undef ML_PREFETCH
}


#if defined(DIAG) && DIAG == 6
__device__ __forceinline__ void mlstm_brute(LAS unsigned char* lds, int b, int h, int dvs, const bf16* MQ, const bf16* MK, const bf16* MLV, const float* IFG, bf16* HML, int tid) {
    const int dv = tid & 63, kg = tid >> 6;
    LAS float* part = (LAS float*)lds;
    LAS float* partd = part + 512;
    float C[16], n[16];
#pragma unroll
    for (int e = 0; e < 16; ++e) { C[e] = 0.f; n[e] = 0.f; }
    float m = 0.f;
    for (int t = 0; t < SEQ; ++t) {
        const size_t tok = (size_t)b * SEQ + t;
        const float iv = IFG[tok * 8 + h], fv = IFG[tok * 8 + 4 + h];
        const float lf = fminf(fv, 0.f) - log1pf(expf(-fabsf(fv)));
        const float mn = fmaxf(lf + m, iv), dec = expf(lf + m - mn), wi = expf(iv - mn); m = mn;
        const v4u k0 = *(const v4u*)(MK + tok * 512 + h * 128 + kg * 16), k1 = *(const v4u*)(MK + tok * 512 + h * 128 + kg * 16 + 8);
        const v4u q0 = *(const v4u*)(MQ + tok * 512 + h * 128 + kg * 16), q1 = *(const v4u*)(MQ + tok * 512 + h * 128 + kg * 16 + 8);
        const unsigned kr[8] = {k0.x, k0.y, k0.z, k0.w, k1.x, k1.y, k1.z, k1.w}, qr[8] = {q0.x, q0.y, q0.z, q0.w, q1.x, q1.y, q1.z, q1.w};
        const unsigned short vr = MLV[tok * 1024 + h * 256 + dvs * 64 + dv]; const float vv = __uint_as_float((unsigned)vr << 16);
        float num = 0.f, den = 0.f;
#pragma unroll
        for (int e = 0; e < 8; ++e) { const float ka = bflo(kr[e]), kb = bfhi(kr[e]), qa = bflo(qr[e]), qb = bfhi(qr[e]);
            C[2 * e] = dec * C[2 * e] + wi * ka * vv; C[2 * e + 1] = dec * C[2 * e + 1] + wi * kb * vv;
            n[2 * e] = dec * n[2 * e] + wi * ka; n[2 * e + 1] = dec * n[2 * e + 1] + wi * kb;
            num += C[2 * e] * qa + C[2 * e + 1] * qb; den += n[2 * e] * qa + n[2 * e + 1] * qb; }
        part[kg * 64 + dv] = num; if (dv == 0) partd[kg] = den;
        __syncthreads();
        if (tid < 64) { float s = 0.f, d = 0.f;
#pragma unroll
            for (int g = 0; g < 8; ++g) { s += part[g * 64 + tid]; d += partd[g]; }
            HML[tok * 1024 + h * 256 + dvs * 64 + tid] = (bf16)f2bf(s / fmaxf(fabsf(d), expf(-m))); }
        __syncthreads();
    }
}
#endif
__device__ __forceinline__ void headnorm_pass(const Ptrs& P, bf16* HML  , const bf16* SIGO, bf16* OATT  , int gw, int NGW, int lane) {
    float wa[16], wb[16];
#pragma unroll
    for (int e = 0; e < 16; ++e) { wa[e] = P.ml_norm_w[16 * lane + e]; wb[e] = P.da_norm_w[16 * lane + e] * 0.8f; }
    for (int m = gw; m < T; m += NGW) {
        { v4u* p = (v4u*)(HML + (size_t)m * 1024 + 16 * lane); const v4u a = p[0], b = p[1]; const v4u* sp = (const v4u*)(SIGO + (size_t)m * 1024 + 16 * lane); const v4u s0 = sp[0], s1 = sp[1];
          const unsigned xr[8] = {a.x, a.y, a.z, a.w, b.x, b.y, b.z, b.w}, sr[8] = {s0.x, s0.y, s0.z, s0.w, s1.x, s1.y, s1.z, s1.w};
          float x[16], sg[16]; float sum = 0.f;
#pragma unroll
          for (int e = 0; e < 8; ++e) { x[2 * e] = bflo(xr[e]); x[2 * e + 1] = bfhi(xr[e]); sg[2 * e] = bflo(sr[e]); sg[2 * e + 1] = bfhi(sr[e]); sum += x[2 * e] + x[2 * e + 1]; }
#pragma unroll
          for (int o = 1; o < 16; o <<= 1) sum += __shfl_xor(sum, o);
          const float mu = sum * (1.0f / 256.0f); float q = 0.f;
#pragma unroll
          for (int e = 0; e < 16; ++e) { x[e] -= mu; q += x[e] * x[e]; }
#pragma unroll
          for (int o = 1; o < 16; o <<= 1) q += __shfl_xor(q, o);
          const float rstd = 1.0f / sqrtf(q * (1.0f / 256.0f) + LN_EPS);
          unsigned ow[8];
#pragma unroll
          for (int e = 0; e < 8; ++e) ow[e] = pk2(x[2 * e] * rstd * wa[2 * e] * sg[2 * e], x[2 * e + 1] * rstd * wa[2 * e + 1] * sg[2 * e + 1]);
          p[0] = (v4u){ow[0], ow[1], ow[2], ow[3]}; p[1] = (v4u){ow[4], ow[5], ow[6], ow[7]}; }
        { v4u* p = (v4u*)(OATT + (size_t)m * 1024 + 16 * lane); const v4u a = p[0], b = p[1];
          const unsigned xr[8] = {a.x, a.y, a.z, a.w, b.x, b.y, b.z, b.w};
          float x[16]; float q = 0.f;
#pragma unroll
          for (int e = 0; e < 8; ++e) { x[2 * e] = bflo(xr[e]); x[2 * e + 1] = bfhi(xr[e]); q += x[2 * e] * x[2 * e] + x[2 * e + 1] * x[2 * e + 1]; }
#pragma unroll
          for (int o = 1; o < 8; o <<= 1) q += __shfl_xor(q, o);
          const float rs = 1.0f / sqrtf(q * (1.0f / 128.0f) + LN_EPS);
          unsigned ow[8];
#pragma unroll
          for (int e = 0; e < 8; ++e) ow[e] = pk2(x[2 * e] * rs * wb[2 * e], x[2 * e + 1] * rs * wb[2 * e + 1]);
          p[0] = (v4u){ow[0], ow[1], ow[2], ow[3]}; p[1] = (v4u){ow[4], ow[5], ow[6], ow[7]}; }
    }
}

__device__ __forceinline__ void ln_pass(const float* IN, const float* g, const float* bta, float* OUTF, bf16* OUTB, int gw, int NGW, int lane) {
    f32x4 gv[4], bv[4];
#pragma unroll
    for (int j = 0; j < 4; ++j) { gv[j] = ((const f32x4*)g)[lane + 64 * j]; bv[j] = ((const f32x4*)bta)[lane + 64 * j]; }
    for (int m = gw; m < T; m += NGW) {
        const f32x4* xr = (const f32x4*)(IN + (size_t)m * D) + lane;
        f32x4 v[4]; float s = 0.f;
#pragma unroll
        for (int j = 0; j < 4; ++j) { v[j] = xr[64 * j]; s += (v[j].x + v[j].y) + (v[j].z + v[j].w); }
        const float mean = wave_sum(s) * (1.f / D); float s2 = 0.f;
#pragma unroll
        for (int j = 0; j < 4; ++j) { v[j] = v[j] - mean; s2 += (v[j].x * v[j].x + v[j].y * v[j].y) + (v[j].z * v[j].z + v[j].w * v[j].w); }
        const float rstd = 1.f / sqrtf(wave_sum(s2) * (1.f / D) + LN_EPS);
        f32x4* of = (f32x4*)(OUTF + (size_t)m * D) + lane;
#pragma unroll
        for (int j = 0; j < 4; ++j) { v[j] = v[j] * rstd * gv[j] + bv[j]; of[64 * j] = v[j]; }
        if (OUTB) { unsigned long long* o8 = (unsigned long long*)(OUTB + (size_t)m * D) + lane;
#pragma unroll
            for (int j = 0; j < 4; ++j) o8[64 * j] = (unsigned long long)pk2(v[j].x, v[j].y) | ((unsigned long long)pk2(v[j].z, v[j].w) << 32); }
    }
}

#define MFMA32(a, b, c) __builtin_amdgcn_mfma_f32_32x32x16_bf16((a), (b), (c), 0, 0, 0)
__device__ __forceinline__ void xattn_unit(LAS unsigned char* lds, int b, int h, int qt, const bf16* XQ, const bf16* XK, const bf16* XVT, bf16* XO, int tid, int wid, int lane) {
    const int r32 = lane & 31, hi = lane >> 5;
    const size_t q = (size_t)b * SEQ + qt * 256 + wid * 32 + r32;
    const bf16* qp = XQ + q * 1024 + h * 256 + hi * 8;
    f32x16 s[8];
#pragma unroll
    for (int i = 0; i < 8; ++i)
#pragma unroll
        for (int r = 0; r < 16; ++r) s[i][r] = 0.f;
#pragma unroll
    for (int hf = 0; hf < 2; ++hf) {
        __syncthreads();
#pragma unroll
        for (int i = 0; i < 8; ++i) { const int p = tid + NTHR * i, row = p >> 5, sg = p & 31;
            *(LAS v4u*)(lds + row * 528 + sg * 16) = *(const v4u*)(XK + (size_t)(b * 256 + hf * 128 + row) * 1024 + h * 256 + sg * 8); }
        __syncthreads();
#pragma unroll 4
        for (int ks = 0; ks < 16; ++ks) { const bf16x8 qf = *(const bf16x8*)(qp + 16 * ks);
#pragma unroll
            for (int t = 0; t < 4; ++t) { const bf16x8 kf = *(const LAS bf16x8*)(lds + (32 * t + r32) * 528 + (16 * ks + 8 * hi) * 2); s[hf * 4 + t] = MFMA32(kf, qf, s[hf * 4 + t]); } }
    }
    float mx = s[0][0];
#pragma unroll
    for (int i = 0; i < 8; ++i)
#pragma unroll
        for (int r = 0; r < 16; ++r) mx = fmaxf(mx, s[i][r]);
    mx = fmaxf(mx, __shfl_xor(mx, 32));
    float l = 0.f;
#pragma unroll
    for (int i = 0; i < 8; ++i)
#pragma unroll
        for (int r = 0; r < 16; ++r) { s[i][r] = __builtin_amdgcn_exp2f(s[i][r] - mx); l += s[i][r]; }
    l += __shfl_xor(l, 32);
    const float rl = 1.0f / l;
    bf16x8 pf[8][2];
#pragma unroll
    for (int i = 0; i < 8; ++i)
#pragma unroll
        for (int st = 0; st < 2; ++st) { v4u w; w.x = pk2(s[i][8 * st], s[i][8 * st + 1]); w.y = pk2(s[i][8 * st + 2], s[i][8 * st + 3]); w.z = pk2(s[i][8 * st + 4], s[i][8 * st + 5]); w.w = pk2(s[i][8 * st + 6], s[i][8 * st + 7]);
            pf[i][st] = __builtin_bit_cast(bf16x8, w); }
#pragma unroll
    for (int dh = 0; dh < 2; ++dh) {
        __syncthreads();
#pragma unroll
        for (int i = 0; i < 8; ++i) { const int p = tid + NTHR * i, row = p >> 5, sg = p & 31;
            *(LAS v4u*)(lds + row * 528 + sg * 16) = *(const v4u*)(XVT + (size_t)(h * 256 + dh * 128 + row) * TM + b * 256 + sg * 8); }
        __syncthreads();
#pragma unroll
        for (int dt = 0; dt < 4; ++dt) { f32x16 o;
#pragma unroll
            for (int r = 0; r < 16; ++r) o[r] = 0.f;
#pragma unroll
            for (int i = 0; i < 8; ++i)
#pragma unroll
                for (int st = 0; st < 2; ++st) { const LAS unsigned char* vp = lds + (32 * dt + r32) * 528 + (32 * i + 16 * st + 4 * hi) * 2;
                    const s16x4 lo = *(const LAS s16x4*)vp, hi4 = *(const LAS s16x4*)(vp + 16);
                    const bf16x8 af = __builtin_shufflevector(lo, hi4, 0, 1, 2, 3, 4, 5, 6, 7); o = MFMA32(af, pf[i][st], o); }
#pragma unroll
            for (int g = 0; g < 4; ++g) { v2u w; w.x = pk2(o[4 * g] * rl, o[4 * g + 1] * rl); w.y = pk2(o[4 * g + 2] * rl, o[4 * g + 3] * rl);
                *(v2u*)(XO + q * 1024 + h * 256 + dh * 128 + 32 * dt + 8 * g + 4 * hi) = w; } }
    }
}

struct Args { const void* in[29]; float* out; unsigned char* ws; };

__global__ void __launch_bounds__(NTHR, 2) fwd_megakernel(Args args) {
    extern __shared__ __attribute__((aligned(16))) unsigned char lds_raw[];
    cg::grid_group grid = cg::this_grid();
#define GRID_SYNC() do { asm volatile("s_waitcnt vmcnt(0) lgkmcnt(0)" ::: "memory"); __syncthreads(); grid.sync(); \
        asm volatile("buffer_inv sc0 sc1\n\ts_waitcnt vmcnt(0)" ::: "memory"); __syncthreads(); } while (0)
    LAS unsigned char* lds = (LAS unsigned char*)lds_raw;
#define L2_FLUSH() do { const v4u* fp_ = (const v4u*)((const unsigned char*)P.w_in + (size_t)(bx & 31) * MiB) + threadIdx.x; unsigned fa_ = 0u; \
        _Pragma("unroll 8") for (int i_ = 0; i_ < 128; ++i_) { const v4u t_ = *(const volatile v4u*)(fp_ + i_ * 512); fa_ |= t_.x ^ t_.y ^ t_.z ^ t_.w; } \
        if (fa_ == 0x12345677u) ((unsigned*)(ws + WS_CHK))[9000] = fa_; } while (0)
    const int G = gridDim.x, bx = blockIdx.x, NGW = G * NWAVES, NGT = G * NTHR;
#define FRESH() int tid = threadIdx.x; asm volatile("" : "+v"(tid)); const int lane = tid & 63, wave = __builtin_amdgcn_readfirstlane(tid >> 6), gw = bx * NWAVES + wave, gt = bx * NTHR + tid; (void)lane; (void)wave; (void)gw; (void)gt
    Ptrs P;
    P.x = (const float*)args.in[0]; P.mem = (const float*)args.in[1]; P.pos = (const int*)args.in[2]; P.w_in = (const float*)args.in[3]; P.b_in = (const float*)args.in[4];
    P.conv_w = (const float*)args.in[5]; P.conv_b = (const float*)args.in[6]; P.ml_norm_w = (const float*)args.in[7];
    P.lq1 = (const float*)args.in[8]; P.lk1 = (const float*)args.in[9]; P.lq2 = (const float*)args.in[10]; P.lk2 = (const float*)args.in[11]; P.da_norm_w = (const float*)args.in[12];
    P.wsq[0] = (const float*)args.in[13]; P.wsq[1] = (const float*)args.in[14]; P.wsq[2] = (const float*)args.in[15]; P.wsq[3] = (const float*)args.in[18]; P.wsq[4] = (const float*)args.in[19];
    P.wsq[5] = (const float*)args.in[20]; P.wsq[6] = (const float*)args.in[21];
    P.ln1g = (const float*)args.in[16]; P.ln1b = (const float*)args.in[17]; P.ln2g = (const float*)args.in[22]; P.ln2b = (const float*)args.in[23]; P.ln3g = (const float*)args.in[27]; P.ln3b = (const float*)args.in[28];
    P.w_gate = (const float*)args.in[24]; P.w_up = (const float*)args.in[25]; P.w_down = (const float*)args.in[26];
    P.out = args.out; P.ws = args.ws;
    unsigned char* ws = args.ws;
    bf16* const S0 = (bf16*)(ws + WS_S0); bf16* const S1 = (bf16*)(ws + WS_S1); bf16* const S2 = (bf16*)(ws + WS_S2); bf16* const S3 = (bf16*)(ws + WS_S3); bf16* const S4 = (bf16*)(ws + WS_S4); bf16* const S5 = (bf16*)(ws + WS_S5);
    bf16* const O0 = (bf16*)args.out; bf16* const O1 = (bf16*)((unsigned char*)args.out + 64 * MiB);
    bf16* const WSQ = (bf16*)(ws + WS_WSQ);
#define WSQ_(j) (WSQ + (size_t)(j) * 1024 * 1024)

#ifndef SKIP_P0
{ FRESH(); p0_prologue(P, lds, gw, NGW, wave, lane, tid); }
#if defined(DIAG) && (DIAG == 9 || DIAG == 10)
    if (bx == 0 && threadIdx.x == 0) { ((float*)(ws + WS_CHK))[8192] = 0.0f; ((int*)(ws + WS_CHK))[8200] = 1000; ((int*)(ws + WS_CHK))[8201] = -1; }
#endif
#endif
    GRID_SYNC();

{ FRESH(); scan_step_a(ws, gw, NGW, lane); }
    {
        pg8::Gemm g{S0, (const bf16*)(ws + WS_WIN1), T, 5120, D}; pg8::StaticOrder S; S.init(T, 5120, G, bx);
        pg8::EpiIn1 E{S1, S2, S3, S4, S5, P.b_in, (const float*)(ws + WS_COS), (const float*)(ws + WS_SIN), 0.125f * LOG2E};
        pg8::gemm_phase<pg8::EpiIn1, pg8::StaticOrder, true, true>(lds, g, S, E);
    }
    {
        pg8::Gemm g{(const bf16*)(ws + WS_MEMB), WSQ_(4), TM, D, D}; pg8::StaticOrder S; S.init(TM, D, G, bx);
        pg8::EpiPlain<0> E{(bf16*)(ws + WS_XK), D, nullptr, 1.0f};
        pg8::gemm_phase<pg8::EpiPlain<0>, pg8::StaticOrder, true, true>(lds, g, S, E);
    }
    {
        pg8::Gemm g{WSQ_(5), (const bf16*)(ws + WS_MEMB), D, TM, D}; pg8::StaticOrder S; S.init(D, TM, G, (bx + 128) % G);
        pg8::EpiPlain<0> E{(bf16*)(ws + WS_XVT), TM, nullptr, 1.0f};
        pg8::gemm_phase<pg8::EpiPlain<0>, pg8::StaticOrder, true, true>(lds, g, S, E);
    }
    GRID_SYNC();

{ FRESH(); scan_step_b(ws, tid); }
#ifndef SKIP_CONV
{ FRESH(); conv_pass(P, S1, O0, O0 + (size_t)T * 512, gt, NGT); }
#endif
    GRID_SYNC();

#ifndef SKIP_MLSTM
    for (int it = bx; it < 256; it += G) { FRESH();
#if defined(DIAG) && DIAG == 6
        mlstm_brute(lds, it >> 4, (it >> 2) & 3, it & 3, O0, O0 + (size_t)T * 512, S2, (const float*)(ws + WS_IFG), S1, tid); }
#else
        mlstm_item(lds, it >> 4, (it >> 2) & 3, it & 3, O0, O0 + (size_t)T * 512, S2, (const f32x4*)(ws + WS_SCT), (const float*)(ws + WS_CHK), (const float*)(ws + WS_MPREV), S1, tid, wave, lane); }
#endif
#endif
    {
        float s1, s2; { FRESH(); s1 = wave_sum(P.lq1[lane] * P.lk1[lane]); s2 = wave_sum(P.lq2[lane] * P.lk2[lane]); }
        const float lam = __int_as_float(__builtin_amdgcn_readfirstlane(__float_as_int(__expf(s1) - __expf(s2) + 0.2f)));
        __syncthreads();
        for (int v = bx; v < 256; v += G) { const int b = v >> 4, h = (v >> 1) & 7, vh = v & 1;
#pragma clang loop unroll(disable)
            for (int i = 0; i < 16; ++i) { int c = i >> 3, qb = 7 - (i & 7); asm volatile("" : "+s"(c), "+s"(qb));
#ifndef SKIP_ATTN
                attn_body::attn_unit<8>(b, (2 * h + c) * 64, h * 128 + vh * 64, qb, (const attn_body::bf16*)S3, (const attn_body::bf16*)S4, (const attn_body::bf16*)S5, (attn_body::bf16*)O1, (char*)lds_raw, c == 1, lam);
#endif
            } }
    }
    GRID_SYNC();

    {
        pg8::Gemm g{S0, (const bf16*)(ws + WS_WIN2), T, 3072, D}; pg8::StaticOrder S; S.init(T, 3072, G, bx);
        pg8::EpiIn2 E{S2, S3, P.b_in};
        pg8::gemm_phase<pg8::EpiIn2, pg8::StaticOrder, true, true>(lds, g, S, E);
    }
    L2_FLUSH();
    GRID_SYNC();

#if defined(DIAG) && DIAG == 10
    { FRESH(); float bad = 0.f;
      for (size_t i = gt; i < (size_t)T * D; i += NGT) { const float xv = P.x[i]; const float g = __uint_as_float((unsigned)S0[i] << 16); if (fabsf(g - xv) > 0.01f * fabsf(xv) + 1e-6f) bad += 1.f; }
      if (bad != 0.f) atomicAdd(&((float*)(ws + WS_CHK))[8192], bad); }
#endif
#if defined(DIAG) && DIAG == 9
    {
        FRESH();
        if (bx == 0) {
            float bad = 0.f;
            for (int i = tid; i < 4096; i += NTHR) {
                const int r = i & 255, c = (i * 37) % 3072;
                const int wcol = c < 1024 ? 2048 + c : 6152 + (c - 1024);
                float acc = P.b_in[wcol];
                for (int k = 0; k < D; ++k) acc += P.x[(size_t)r * D + k] * P.w_in[(size_t)k * INDIM + wcol];
                const float ref = 1.0f / (1.0f + expf(-acc));
                const unsigned short got16 = c < 1024 ? S2[(size_t)r * 1024 + c] : S3[(size_t)r * 2048 + (c - 1024)];
                const float got = __uint_as_float((unsigned)got16 << 16);
#ifndef PROBE_WHICH
#define PROBE_WHICH 0
#endif
                if (PROBE_WHICH == 5) { const int n = c, k = r & 1023; const int wc2 = n < 1024 ? 2048 + n : 6152 + (n - 1024);
                    const float wv = P.w_in[(size_t)k * INDIM + wc2]; const float gv2 = __uint_as_float((unsigned)((const bf16*)(ws + WS_WIN2))[(size_t)n * 1024 + k] << 16);
                    if (fabsf(gv2 - wv) > 0.01f * fabsf(wv) + 1e-6f) bad = 1.f; }
                else if (PROBE_WHICH == 4) { const int k = c & 1023; const float xv = P.x[(size_t)r * D + k]; const float gv2 = __uint_as_float((unsigned)S0[(size_t)r * 1024 + k] << 16);
                    if (fabsf(gv2 - xv) > 0.01f * fabsf(xv) + 1e-6f) bad = 1.f; }
                else
                if (PROBE_WHICH == 3) { const int c2 = c & 1023; float a2 = P.b_in[5128 + c2];
                    for (int k = 0; k < D; ++k) a2 += P.x[(size_t)r * D + k] * P.w_in[(size_t)k * INDIM + 5128 + c2];
                    const float g2 = __uint_as_float((unsigned)S5[(size_t)r * 1024 + c2] << 16);
                    if (fabsf(g2 - a2) > 0.06f) bad = 1.f; }
                else
                if ((PROBE_WHICH == 0 || (PROBE_WHICH == 1 && c < 1024) || (PROBE_WHICH == 2 && c >= 1024)) && fabsf(got - ref) > 0.02f) { bad += 1.f; atomicMin((int*)(ws + WS_CHK) + 8200, r >> 8); atomicMax((int*)(ws + WS_CHK) + 8201, r >> 8); }
            }
            if (bad != 0.f) atomicAdd(&((float*)(ws + WS_CHK))[8192], bad);
        }
    }
#endif
#ifndef SKIP_HN
{ FRESH(); headnorm_pass(P, S1, S2, O1, gw, NGW, lane); }
#if defined(DIAG) && (DIAG == 1 || DIAG == 2)
    GRID_SYNC();
    { FRESH(); v4u* p = (v4u*)(DIAG == 1 ? (bf16*)S1 : (bf16*)O1); for (size_t i = gt; i < (size_t)T * 1024 / 8; i += NGT) p[i] = (v4u){0u, 0u, 0u, 0u}; }
#endif
#endif
    GRID_SYNC();

    {
        pg8::Gemm g{S1, WSQ_(0), T, D, D}; pg8::StaticOrder S; S.init(T, D, G, bx);
        pg8::EpiGate<false> E{S2, S3, nullptr};
        pg8::gemm_phase<pg8::EpiGate<false>, pg8::StaticOrder, true, true>(lds, g, S, E);
    }
    {
        pg8::Gemm g{O1, WSQ_(1), T, D, D}; pg8::StaticOrder S; S.init(T, D, G, bx);
        pg8::EpiGate<true> E{S5, S3, S2};
        pg8::gemm_phase<pg8::EpiGate<true>, pg8::StaticOrder, true, true>(lds, g, S, E);
    }
    GRID_SYNC();

#if defined(DIAG) && DIAG == 7
    { FRESH(); v4u* p = (v4u*)S5; for (size_t i = gt; i < (size_t)T * 1024 / 8; i += NGT) p[i] = (v4u){0u, 0u, 0u, 0u}; }
    GRID_SYNC();
#endif
    {
        pg8::Gemm g{S5, WSQ_(2), T, D, D}; pg8::StaticOrder S; S.init(T, D, G, bx);
        pg8::EpiRes E{P.x, (float*)S1, ALPHA};
        pg8::gemm_phase<pg8::EpiRes, pg8::StaticOrder, true, true>(lds, g, S, E);
    }
    GRID_SYNC();
{ FRESH(); ln_pass((const float*)S1, P.ln1g, P.ln1b, (float*)S3, S0, gw, NGW, lane); }
    GRID_SYNC();

    {
        pg8::Gemm g{S0, WSQ_(3), T, D, D}; pg8::StaticOrder S; S.init(T, D, G, bx);
        pg8::EpiPlain<0> E{S5, D, nullptr, 0.0625f * LOG2E};
        pg8::gemm_phase<pg8::EpiPlain<0>, pg8::StaticOrder, true, true>(lds, g, S, E);
    }
    GRID_SYNC();

#ifndef SKIP_XATTN
    for (int u = bx; u < 512; u += G) { FRESH(); xattn_unit(lds, u >> 5, (u >> 3) & 3, u & 7, S5, (const bf16*)(ws + WS_XK), (const bf16*)(ws + WS_XVT), S1, tid, wave, lane); }
#endif
    __syncthreads();
#if defined(DIAG) && DIAG == 3
    GRID_SYNC();
    { FRESH(); v4u* p = (v4u*)S1; for (size_t i = gt; i < (size_t)T * 1024 / 8; i += NGT) p[i] = (v4u){0u, 0u, 0u, 0u}; }
#endif
    GRID_SYNC();

    {
        pg8::Gemm g{S1, WSQ_(6), T, D, D}; pg8::StaticOrder S; S.init(T, D, G, bx);
        pg8::EpiRes E{(const float*)S3, args.out, ALPHA};
        pg8::gemm_phase<pg8::EpiRes, pg8::StaticOrder, true, true>(lds, g, S, E);
    }
    GRID_SYNC();
{ FRESH(); ln_pass(args.out, P.ln2g, P.ln2b, args.out, S0, gw, NGW, lane); }
    GRID_SYNC();

    {
        pg8::Gemm g{S0, (const bf16*)(ws + WS_WGU), T, 2 * FF, D}; pg8::StaticOrder S; S.init(T, 2 * FF, G, bx);
        pg8::EpiSwiglu E{S1, FF};
        pg8::gemm_phase<pg8::EpiSwiglu, pg8::StaticOrder, true, true>(lds, g, S, E);
    }
    GRID_SYNC();

#if defined(DIAG) && DIAG == 4
    { FRESH(); v4u* p = (v4u*)S1; for (size_t i = gt; i < (size_t)T * FF / 8; i += NGT) p[i] = (v4u){0u, 0u, 0u, 0u}; }
    GRID_SYNC();
#endif
    {
        pg8::Gemm g{S1, (const bf16*)(ws + WS_WDN), T, D, FF}; pg8::StaticOrder S; S.init(T, D, G, bx);
        pg8::EpiRes E{args.out, (float*)S4, ALPHA};
        pg8::gemm_phase<pg8::EpiRes, pg8::StaticOrder, true, true>(lds, g, S, E);
    }
    GRID_SYNC();
{ FRESH(); ln_pass((const float*)S4, P.ln3g, P.ln3b, args.out, nullptr, gw, NGW, lane); }
#if defined(DIAG) && (DIAG == 9 || DIAG == 10)
    GRID_SYNC();
    if (bx == 0 && threadIdx.x == 0) { const float cnt = ((float*)(ws + WS_CHK))[8192]; args.out[0] = cnt > 0.f ? exp2f(3.0f + log2f(cnt)) : 4.0f; }
#endif
}

extern "C" void kernel_launch(void* const* d_in, const int* in_sizes, int n_in, void* d_out, int out_size, void* d_ws, size_t ws_size, hipStream_t stream) {
    static int grid = 0;
    if (grid == 0) {
        if (n_in != 29 || out_size != T * D || ws_size < WS_END) { fprintf(stderr, "kernel_launch: unexpected problem (n_in %d, out %d, ws %zu); nothing launched\n", n_in, out_size, ws_size); grid = -1; return; }
        int dev = 0, cus = 0, per_cu = 0;
        if (hipGetDevice(&dev) != hipSuccess || hipDeviceGetAttribute(&cus, hipDeviceAttributeMultiprocessorCount, dev) != hipSuccess) { grid = -1; return; }
        if (hipFuncSetAttribute((const void*)fwd_megakernel, hipFuncAttributeMaxDynamicSharedMemorySize, LDS_BYTES) != hipSuccess) { fprintf(stderr, "kernel_launch: hipFuncSetAttribute failed\n"); grid = -1; return; }
        if (hipOccupancyMaxActiveBlocksPerMultiprocessor(&per_cu, (const void*)fwd_megakernel, NTHR, LDS_BYTES) != hipSuccess || per_cu < 1) { fprintf(stderr, "kernel_launch: occupancy query gave %d\n", per_cu); per_cu = 1; }
        (void)hipGetLastError();
        grid = cus * per_cu;
        fprintf(stderr, "kernel_launch: grid %d (cus %d x %d), ws %zu\n", grid, cus, per_cu, ws_size);
    }
    if (grid < 0) return;
    Args a{};
    for (int i = 0; i < 29; ++i) a.in[i] = d_in[i];
    a.out = (float*)d_out; a.ws = (unsigned char*)d_ws;
    void* kargs[] = {&a};
    const hipError_t e = hipLaunchCooperativeKernel((const void*)fwd_megakernel, dim3(grid), dim3(NTHR), kargs, LDS_BYTES, stream);
    if (e != hipSuccess) fprintf(stderr, "kernel_launch: cooperative launch failed: %s (grid %d)\n", hipGetErrorString(e), grid);
}
```

```cpp
#include <hip/hip_runtime.h>
#include <hip/hip_cooperative_groups.h>
#include <cstdio>
#include <cstdint>
namespace cg = cooperative_groups;
namespace pg8 {
#define PG8_LAS __attribute__((address_space(3)))
typedef unsigned short bf16_t;
typedef short bf16x8 __attribute__((ext_vector_type(8)));
typedef float f32x4 __attribute__((ext_vector_type(4)));
typedef unsigned u32x4 __attribute__((ext_vector_type(4)));
constexpr int BM = 256, BK = 64, HALF = 128, HTB = HALF * BK * 2  , STAGE_BYTES = 8 * HTB, NXCD = 8, WGM = 8;

__host__ __device__ __forceinline__ int lds_byte(int r, int c) { const int st = (r >> 4) * 2 + (c >> 5), rr = r & 15, cc = c & 31, ob = rr * 64 + cc * 2; return st * 1024 + (ob ^ (((ob >> 9) & 1) << 5)); }
__host__ __device__ __forceinline__ void stage_rc(int b, int& R, int& C) { const int st = b / 1024, sb = b % 1024, swz = sb ^ (((sb >> 9) & 1) << 5); R = (st >> 1) * 16 + swz / 64; C = (st & 1) * 32 + (swz % 64) / 2; }
__host__ __device__ __forceinline__ int perm32(int rho) { const int n = rho >> 4, i = rho & 15; return 8 * (i >> 2) + 4 * n + (i & 3); }

struct Unit { int pm, pn; };
struct Gemm { const bf16_t* A; const bf16_t* Bt; int M, N, K; };

struct StaticOrder {
    int nM, nN, nwg, G, c;
    __host__ __device__ void init(int M, int N, int G_, int c_) { nM = M / BM; nN = N / BM; nwg = nM * nN; G = G_; c = c_; }
    __host__ __device__ bool next(int i, Unit& u) const {
        const long L = (long)i * G + c; if (L >= nwg) return false;
        int wgid = (int)L; { const int q = nwg / NXCD, r = nwg % NXCD, xcd = wgid % NXCD, off = wgid / NXCD; wgid = (xcd < r ? xcd * (q + 1) : r * (q + 1) + (xcd - r) * q) + off; }
        const int nig = WGM * nN, gid = wgid / nig, fm = gid * WGM, gsz = (nM - fm) < WGM ? (nM - fm) : WGM;
        u.pm = fm + ((wgid % nig) % gsz); u.pn = (wgid % nig) / gsz; return true;
    }
    __device__ __forceinline__ void a_ready(const Unit&) const {}
    __device__ __forceinline__ void done(const Unit&) const {}
};

__device__ __forceinline__ unsigned cvt_pk_bf16(float lo, float hi) { unsigned r; asm volatile("s_nop 1\n\tv_cvt_pk_bf16_f32 %0, %1, %2" : "=v"(r) : "v"(lo), "v"(hi)); return r; }
typedef float f32x2 __attribute__((ext_vector_type(2)));
typedef unsigned u32x2 __attribute__((ext_vector_type(2)));
__device__ __forceinline__ float fsigmoid(float x) { return __builtin_amdgcn_rcpf(1.0f + __builtin_amdgcn_exp2f(-1.4426950408889634f * x)); }
__device__ __forceinline__ float bflo(unsigned w) { return __uint_as_float(w << 16); }
__device__ __forceinline__ float bfhi(unsigned w) { return __uint_as_float(w & 0xffff0000u); }
__device__ __forceinline__ u32x4 pack8(const f32x4 v0, const f32x4 v1) { u32x4 w; w.x = cvt_pk_bf16(v0[0], v0[1]); w.y = cvt_pk_bf16(v0[2], v0[3]); w.z = cvt_pk_bf16(v1[0], v1[1]); w.w = cvt_pk_bf16(v1[2], v1[3]); return w; }

template <int ACT  > struct EpiPlain {
    static constexpr bool PERM = true, AFTER_DRAIN = false;
    bf16_t* O; int ldc; const float* bias; float scale;
    __device__ __forceinline__ void operator()(const f32x4 (&acc)[2][2][4][2], const Unit& u, int wr, int wc, int fr, int fq) const {
        const int row0 = u.pm * BM + wr * 64 + fr, col0 = u.pn * BM + wc * 32 + 8 * fq;
        f32x4 bv[2][2];
#pragma unroll
        for (int bj = 0; bj < 2; ++bj)
#pragma unroll
            for (int n = 0; n < 2; ++n) bv[bj][n] = bias ? *(const f32x4*)(bias + col0 + bj * HALF + 4 * n) : (f32x4){0.f, 0.f, 0.f, 0.f};
#pragma unroll
        for (int ai = 0; ai < 2; ++ai)
#pragma unroll
            for (int m = 0; m < 4; ++m) { bf16_t* rowp = O + (size_t)(row0 + ai * HALF + m * 16) * ldc + col0;
#pragma unroll
                for (int bj = 0; bj < 2; ++bj) { f32x4 v0 = (acc[ai][bj][m][0] + bv[bj][0]) * scale, v1 = (acc[ai][bj][m][1] + bv[bj][1]) * scale;
                    if (ACT == 1) {
#pragma unroll
                        for (int e = 0; e < 4; ++e) { v0[e] = fsigmoid(v0[e]); v1[e] = fsigmoid(v1[e]); } }
                    *(u32x4*)(rowp + bj * HALF) = pack8(v0, v1); } }
    }
};

struct EpiIn1 {
    static constexpr bool PERM = true, AFTER_DRAIN = false;
    bf16_t *QKRAW, *MLV, *DQ, *DK, *DV; const float* bin; const float *COS, *SIN; float qscale;
    __device__ __forceinline__ void operator()(const f32x4 (&acc)[2][2][4][2], const Unit& u, int wr, int wc, int fr, int fq) const {
        const int pn = u.pn, row0 = u.pm * BM + wr * 64 + fr;
        if (pn < 8 || pn >= 16) {
            bf16_t* base; int cb, bb;
            if (pn < 4) { base = QKRAW; cb = pn * 256; bb = pn * 256; }
            else if (pn < 8) { base = MLV; cb = (pn - 4) * 256; bb = 1024 + (pn - 4) * 256; }
            else { base = DV; cb = (pn - 16) * 256; bb = 5128 + (pn - 16) * 256; }
            const int col0 = cb + wc * 32 + 8 * fq; const float* bp = bin + bb + wc * 32 + 8 * fq;
            f32x4 bv[2][2];
#pragma unroll
            for (int bj = 0; bj < 2; ++bj)
#pragma unroll
                for (int n = 0; n < 2; ++n) bv[bj][n] = *(const f32x4*)(bp + bj * HALF + 4 * n);
#pragma unroll
            for (int ai = 0; ai < 2; ++ai)
#pragma unroll
                for (int m = 0; m < 4; ++m) { bf16_t* rowp = base + (size_t)(row0 + ai * HALF + m * 16) * 1024 + col0;
#pragma unroll
                    for (int bj = 0; bj < 2; ++bj) *(u32x4*)(rowp + bj * HALF) = pack8(acc[ai][bj][m][0] + bv[bj][0], acc[ai][bj][m][1] + bv[bj][1]); }
        } else {
            const bool isq = pn < 12; bf16_t* base = isq ? DQ : DK; const int t4 = isq ? pn - 8 : pn - 12;
            const float sc = isq ? qscale : 1.0f;
            const int lc = t4 * 256 + wc * 64 + 8 * fq;
            const float* bp = bin + (isq ? 3080 : 4104) + lc;
            f32x4 bl[2], bh[2];
#pragma unroll
            for (int n = 0; n < 2; ++n) { bl[n] = *(const f32x4*)(bp + 4 * n); bh[n] = *(const f32x4*)(bp + 32 + 4 * n); }
#pragma unroll
            for (int ai = 0; ai < 2; ++ai)
#pragma unroll
                for (int m = 0; m < 4; ++m) { const size_t row = (size_t)(row0 + ai * HALF + m * 16);
                    f32x4 lo[2], hi[2];
#pragma unroll
                    for (int n = 0; n < 2; ++n) { const f32x4 cs = *(const f32x4*)(COS + row * 32 + 8 * fq + 4 * n), sn = *(const f32x4*)(SIN + row * 32 + 8 * fq + 4 * n);
                        const f32x4 a = acc[ai][0][m][n] + bl[n], b = acc[ai][1][m][n] + bh[n];
                        lo[n] = (a * cs - b * sn) * sc; hi[n] = (b * cs + a * sn) * sc; }
                    bf16_t* rowp = base + row * 1024 + lc;
                    *(u32x4*)(rowp) = pack8(lo[0], lo[1]); *(u32x4*)(rowp + 32) = pack8(hi[0], hi[1]); }
        }
    }
};

struct EpiIn2 {
    static constexpr bool PERM = true, AFTER_DRAIN = false;
    bf16_t *SIGO, *GATES; const float* bin;
    __device__ __forceinline__ void operator()(const f32x4 (&acc)[2][2][4][2], const Unit& u, int wr, int wc, int fr, int fq) const {
        const int pn = u.pn, row0 = u.pm * BM + wr * 64 + fr;
        bf16_t* base; int cb, bb, ldc;
        if (pn < 4) { base = SIGO; cb = pn * 256; bb = 2048 + pn * 256; ldc = 1024; }
        else { base = GATES; cb = (pn - 4) * 256; bb = 6152 + (pn - 4) * 256; ldc = 2048; }
        const int col0 = cb + wc * 32 + 8 * fq; const float* bp = bin + bb + wc * 32 + 8 * fq;
        f32x4 bv[2][2];
#pragma unroll
        for (int bj = 0; bj < 2; ++bj)
#pragma unroll
            for (int n = 0; n < 2; ++n) bv[bj][n] = *(const f32x4*)(bp + bj * HALF + 4 * n);
#pragma unroll
        for (int ai = 0; ai < 2; ++ai)
#pragma unroll
            for (int m = 0; m < 4; ++m) { bf16_t* rowp = base + (size_t)(row0 + ai * HALF + m * 16) * ldc + col0;
#pragma unroll
                for (int bj = 0; bj < 2; ++bj) { f32x4 v0 = acc[ai][bj][m][0] + bv[bj][0], v1 = acc[ai][bj][m][1] + bv[bj][1];
#pragma unroll
                    for (int e = 0; e < 4; ++e) { v0[e] = fsigmoid(v0[e]); v1[e] = fsigmoid(v1[e]); }
                    *(u32x4*)(rowp + bj * HALF) = pack8(v0, v1); } }
    }
};

template <bool SECOND> struct EpiGate {
    static constexpr bool PERM = true, AFTER_DRAIN = false;
    bf16_t* O; const bf16_t* G; const bf16_t* OIN;
    __device__ __forceinline__ void operator()(const f32x4 (&acc)[2][2][4][2], const Unit& u, int wr, int wc, int fr, int fq) const {
        const int row0 = u.pm * BM + wr * 64 + fr, col0 = u.pn * BM + wc * 32 + 8 * fq;
#pragma unroll
        for (int ai = 0; ai < 2; ++ai)
#pragma unroll
            for (int m = 0; m < 4; ++m) { const size_t row = (size_t)(row0 + ai * HALF + m * 16);
#pragma unroll
                for (int bj = 0; bj < 2; ++bj) { const int c = col0 + bj * HALF;
#if defined(DIAG) && DIAG == 8
                    const u32x4 g = (u32x4){0x3f003f00u, 0x3f003f00u, 0x3f003f00u, 0x3f003f00u};
#else
                    const u32x4 g = *(const u32x4*)(G + row * 2048 + (SECOND ? 1024 : 0) + c);
#endif
                    f32x4 v0 = acc[ai][bj][m][0], v1 = acc[ai][bj][m][1];
                    v0[0] *= bflo(g.x); v0[1] *= bfhi(g.x); v0[2] *= bflo(g.y); v0[3] *= bfhi(g.y);
                    v1[0] *= bflo(g.z); v1[1] *= bfhi(g.z); v1[2] *= bflo(g.w); v1[3] *= bfhi(g.w);
                    if (SECOND) { const u32x4 o = *(const u32x4*)(OIN + row * 1024 + c);
                        v0[0] += bflo(o.x); v0[1] += bfhi(o.x); v0[2] += bflo(o.y); v0[3] += bfhi(o.y);
                        v1[0] += bflo(o.z); v1[1] += bfhi(o.z); v1[2] += bflo(o.w); v1[3] += bfhi(o.w); }
                    *(u32x4*)(O + row * 1024 + c) = pack8(v0, v1); } }
    }
};

struct EpiRes {
    static constexpr bool PERM = false, AFTER_DRAIN = false;
    const float* X; float* OUT; float alpha;
    __device__ __forceinline__ void operator()(const f32x4 (&acc)[2][2][4][2], const Unit& u, int wr, int wc, int fr, int fq) const {
        const int row0 = u.pm * BM + wr * 64 + fr, col0 = u.pn * BM + wc * 32 + 4 * fq;
#pragma unroll
        for (int ai = 0; ai < 2; ++ai)
#pragma unroll
            for (int m = 0; m < 4; ++m) { const size_t off = (size_t)(row0 + ai * HALF + m * 16) * 1024 + col0;
#pragma unroll
                for (int bj = 0; bj < 2; ++bj)
#pragma unroll
                    for (int n = 0; n < 2; ++n) { const f32x4 xv = *(const f32x4*)(X + off + bj * HALF + n * 16);
                        *(f32x4*)(OUT + off + bj * HALF + n * 16) = xv * alpha + acc[ai][bj][m][n]; } }
    }
};

struct EpiSwiglu {
    static constexpr bool PERM = true, AFTER_DRAIN = false;
    bf16_t* HID; int ldc;
    __device__ __forceinline__ void operator()(const f32x4 (&acc)[2][2][4][2], const Unit& u, int wr, int wc, int fr, int fq) const {
        const int row0 = u.pm * BM + wr * 64 + fr, col0 = u.pn * HALF + wc * 32 + 8 * fq;
#pragma unroll
        for (int ai = 0; ai < 2; ++ai)
#pragma unroll
            for (int m = 0; m < 4; ++m) { f32x4 v[2];
#pragma unroll
                for (int n = 0; n < 2; ++n) { const f32x4 g = acc[ai][0][m][n], up = acc[ai][1][m][n];
#pragma unroll
                    for (int e = 0; e < 4; ++e) v[n][e] = g[e] * fsigmoid(g[e]) * up[e]; }
                *(u32x4*)(HID + (size_t)(row0 + ai * HALF + m * 16) * ldc + col0) = pack8(v[0], v[1]); }
    }
};
template <class Epi, class Sched, bool ALIGN_EPI = false, bool SP2 = false>
__device__ __forceinline__ void gemm_phase(PG8_LAS unsigned char* lds, const Gemm g, const Sched& S, const Epi& E) {
    int tid_ = threadIdx.x; asm volatile("" : "+v"(tid_));
    const int tid = tid_, wid = __builtin_amdgcn_readfirstlane(tid >> 6), lane = tid & 63, wr = wid >> 2, wc = wid & 3, fr = lane & 15, fq = lane >> 4;
    const int K = g.K, nt = K / BK;
    unsigned voffA[2], voffB[2];
#pragma unroll
    for (int i = 0; i < 2; ++i) { int R, C; stage_rc(tid * 16 + i * 8192, R, C); const int Rb = Epi::PERM ? ((R & ~31) + perm32(R & 31)) : R;
        voffA[i] = (unsigned)(R * K + C) * 2u; voffB[i] = (unsigned)(Rb * K + C) * 2u; }
    const size_t kstep = (size_t)(BK * 2);
    const size_t hstep = (size_t)HALF * K * 2;
    const size_t tstep = 2 * hstep;
    const unsigned ldsw = (unsigned)wid * 1024u;
    const int aoff = lds_byte(wr * 64 + fr, fq * 8), boff = lds_byte(wc * 32 + fr, fq * 8);
#define PG8_SA(b, h) (((b) * 2 + (h)) * HTB)
#define PG8_SB(b, h) ((4 + (b) * 2 + (h)) * HTB)
#define PG8_STAGE(bufoff, gbase, voff) do { _Pragma("unroll") for (int _i = 0; _i < 2; ++_i) \
        __builtin_amdgcn_global_load_lds((const unsigned*)((const char*)(gbase) + (voff)[_i]), (PG8_LAS unsigned*)(lds + (bufoff) + ldsw + _i * 8192), 16, 0, 0); } while (0)
#define PG8_LDA(dst, b, h) do { _Pragma("unroll") for (int m = 0; m < 4; ++m) _Pragma("unroll") for (int k = 0; k < 2; ++k) dst[m][k] = *(const PG8_LAS bf16x8*)(lds + PG8_SA(b, h) + aoff + m * 2048 + k * 1024); } while (0)
#define PG8_LDB(dst, b, h) do { _Pragma("unroll") for (int n = 0; n < 2; ++n) _Pragma("unroll") for (int k = 0; k < 2; ++k) dst[n][k] = *(const PG8_LAS bf16x8*)(lds + PG8_SB(b, h) + boff + n * 2048 + k * 1024); } while (0)
#define PG8_MMA(ai, bj, At, Bt) do { __builtin_amdgcn_s_setprio(1); _Pragma("unroll") for (int m = 0; m < 4; ++m) _Pragma("unroll") for (int n = 0; n < 2; ++n) _Pragma("unroll") for (int k = 0; k < 2; ++k) \
        acc[ai][bj][m][n] = __builtin_amdgcn_mfma_f32_16x16x32_bf16(Bt[n][k], At[m][k], acc[ai][bj][m][n], 0, 0, 0); __builtin_amdgcn_s_setprio(0); } while (0)
#define PG8_WAIT_V(n) asm volatile("s_waitcnt vmcnt(" #n ")" ::: "memory")
#define PG8_WAIT_L(n) asm volatile("s_waitcnt lgkmcnt(" #n ")" ::: "memory")
#define PG8_BAR __builtin_amdgcn_s_barrier()
#define PG8_SCHED __builtin_amdgcn_sched_barrier(0)
    Unit cur, nxt; int ui = 0;
    if (!S.next(0, cur)) return;
    f32x4 acc[2][2][4][2];
#pragma unroll
    for (int a = 0; a < 2; ++a)
#pragma unroll
        for (int b = 0; b < 2; ++b)
#pragma unroll
            for (int m = 0; m < 4; ++m)
#pragma unroll
                for (int n = 0; n < 2; ++n) acc[a][b][m][n] = (f32x4){0.f, 0.f, 0.f, 0.f};
    bf16x8 At[4][2], B0[2][2], B1[2][2];
    const char* cA = (const char*)g.A + (size_t)cur.pm * tstep; const char* cB = (const char*)g.Bt + (size_t)cur.pn * tstep;
    S.a_ready(cur);
    if constexpr (SP2) {
        PG8_STAGE(PG8_SB(0, 0), cB, voffB); PG8_STAGE(PG8_SB(0, 1), cB + hstep, voffB); PG8_STAGE(PG8_SA(0, 0), cA, voffA); PG8_STAGE(PG8_SA(0, 1), cA + hstep, voffA);
        if (wr == 1) PG8_BAR;
        PG8_WAIT_V(2); PG8_BAR;
        PG8_STAGE(PG8_SB(1, 0), cB + kstep, voffB); PG8_STAGE(PG8_SA(1, 0), cA + kstep, voffA); PG8_STAGE(PG8_SB(1, 1), cB + hstep + kstep, voffB);
        PG8_WAIT_V(6); PG8_BAR;
    } else {
        PG8_STAGE(PG8_SB(0, 0), cB, voffB); PG8_STAGE(PG8_SA(0, 0), cA, voffA); PG8_STAGE(PG8_SB(0, 1), cB + hstep, voffB); PG8_STAGE(PG8_SA(0, 1), cA + hstep, voffA);
        if (wr == 1) PG8_BAR;
        PG8_WAIT_V(4); PG8_BAR;
        PG8_STAGE(PG8_SB(1, 0), cB + kstep, voffB); PG8_STAGE(PG8_SA(1, 0), cA + kstep, voffA); PG8_STAGE(PG8_SB(1, 1), cB + hstep + kstep, voffB);
        PG8_WAIT_V(6); PG8_BAR;
    }
    for (;;) {
        const bool has_next = S.next(ui + 1, nxt);
        const char* nA = has_next ? (const char*)g.A + (size_t)nxt.pm * tstep : cA; const char* nB = has_next ? (const char*)g.Bt + (size_t)nxt.pn * tstep : cB;
        for (int t = 0; t < nt; t += 2) {
            const bool last = (t == nt - 2);
            const char* a1 = cA + (size_t)(t + 1) * kstep;
            const char* a2 = last ? nA : cA + (size_t)(t + 2) * kstep; const char* b2 = last ? nB : cB + (size_t)(t + 2) * kstep;
            const char* a3 = a2 + kstep; const char* b3 = b2 + kstep;
            if (last && has_next) S.a_ready(nxt);
            if constexpr (SP2) {
            PG8_LDB(B0, 0, 0); PG8_LDB(B1, 0, 1); PG8_SCHED; PG8_LDA(At, 0, 0); PG8_STAGE(PG8_SA(1, 1), a1 + hstep, voffA);
            PG8_WAIT_V(8); PG8_WAIT_L(0); PG8_BAR; PG8_MMA(0, 0, At, B0); PG8_MMA(0, 1, At, B1); PG8_BAR; PG8_SCHED;
            PG8_LDA(At, 0, 1); PG8_STAGE(PG8_SB(0, 0), b2, voffB); PG8_STAGE(PG8_SB(0, 1), b2 + hstep, voffB); PG8_STAGE(PG8_SA(0, 0), a2, voffA);
            PG8_WAIT_V(8); PG8_WAIT_L(0); PG8_BAR; PG8_MMA(1, 0, At, B0); PG8_MMA(1, 1, At, B1); PG8_BAR; PG8_SCHED;
            PG8_LDB(B0, 1, 0); PG8_LDB(B1, 1, 1); PG8_SCHED; PG8_LDA(At, 1, 0); PG8_STAGE(PG8_SA(0, 1), a2 + hstep, voffA);
            PG8_WAIT_V(8); PG8_WAIT_L(0); PG8_BAR; PG8_MMA(0, 0, At, B0); PG8_MMA(0, 1, At, B1); PG8_BAR; PG8_SCHED;
            PG8_LDA(At, 1, 1); PG8_STAGE(PG8_SB(1, 0), b3, voffB); PG8_STAGE(PG8_SB(1, 1), b3 + hstep, voffB); PG8_STAGE(PG8_SA(1, 0), a3, voffA);
            PG8_WAIT_V(8); PG8_WAIT_L(0); PG8_BAR; PG8_MMA(1, 0, At, B0); PG8_MMA(1, 1, At, B1); PG8_BAR; PG8_SCHED;
            } else {
            PG8_LDB(B0, 0, 0); PG8_SCHED; PG8_LDA(At, 0, 0); PG8_STAGE(PG8_SA(1, 1), a1 + hstep, voffA);
            PG8_WAIT_L(8); PG8_BAR; PG8_WAIT_L(0); PG8_MMA(0, 0, At, B0); PG8_BAR; PG8_SCHED;
            PG8_LDB(B1, 0, 1); PG8_STAGE(PG8_SB(0, 0), b2, voffB);
            PG8_BAR; PG8_WAIT_L(0); PG8_MMA(0, 1, At, B1); PG8_BAR;
            PG8_LDA(At, 0, 1); PG8_STAGE(PG8_SA(0, 0), a2, voffA);
            PG8_BAR; PG8_WAIT_L(0); PG8_MMA(1, 0, At, B0); PG8_BAR; PG8_SCHED;
            PG8_STAGE(PG8_SB(0, 1), b2 + hstep, voffB);
            PG8_WAIT_V(6); PG8_BAR; PG8_MMA(1, 1, At, B1); PG8_BAR;
            PG8_LDB(B0, 1, 0); PG8_SCHED; PG8_LDA(At, 1, 0); PG8_STAGE(PG8_SA(0, 1), a2 + hstep, voffA);
            PG8_WAIT_L(8); PG8_BAR; PG8_WAIT_L(0); PG8_MMA(0, 0, At, B0); PG8_BAR; PG8_SCHED;
            PG8_LDB(B1, 1, 1); PG8_STAGE(PG8_SB(1, 0), b3, voffB);
            PG8_BAR; PG8_WAIT_L(0); PG8_MMA(0, 1, At, B1); PG8_BAR;
            PG8_LDA(At, 1, 1); PG8_STAGE(PG8_SA(1, 0), a3, voffA);
            PG8_BAR; PG8_WAIT_L(0); PG8_MMA(1, 0, At, B0); PG8_BAR; PG8_SCHED;
            PG8_STAGE(PG8_SB(1, 1), b3 + hstep, voffB);
            PG8_WAIT_V(6); PG8_BAR; PG8_MMA(1, 1, At, B1); PG8_BAR;
            }
        }
        if constexpr (ALIGN_EPI) { if (wr == 0) PG8_BAR; }
        if constexpr (!Epi::AFTER_DRAIN) { E(acc, cur, wr, wc, fr, fq); S.done(cur); }
        if (!has_next) break;
#pragma unroll
        for (int a = 0; a < 2; ++a)
#pragma unroll
            for (int b = 0; b < 2; ++b)
#pragma unroll
                for (int m = 0; m < 4; ++m)
#pragma unroll
                    for (int n = 0; n < 2; ++n) acc[a][b][m][n] = (f32x4){0.f, 0.f, 0.f, 0.f};
        cur = nxt; cA = nA; cB = nB; ++ui;
        if constexpr (ALIGN_EPI) { if (wr == 1) PG8_BAR; }
    }
    PG8_WAIT_V(0);
    if constexpr (!ALIGN_EPI) { if (wr == 0) PG8_BAR; }
    PG8_BAR;
    if constexpr (Epi::AFTER_DRAIN) { E.fused(acc, cur, wr, wc, fr, fq, lds, wid, lane); S.done(cur); }
#undef PG8_SA
#undef PG8_SB
#undef PG8_STAGE
#undef PG8_LDA
#undef PG8_LDB
#undef PG8_MMA
#undef PG8_WAIT_V
#undef PG8_WAIT_L
#undef PG8_BAR
#undef PG8_SCHED
}
}
#define PG8_SP2 true
#include <hip/hip_bf16.h>
#include <cmath>
namespace attn_body {
using bf16=__hip_bfloat16;
using bf16x8=__attribute__((ext_vector_type(8)))short;
using s16x4=__attribute__((ext_vector_type(4)))short;
using f32x16=__attribute__((ext_vector_type(16)))float;
using u32x4=__attribute__((ext_vector_type(4)))unsigned;
constexpr int BATCH=16,NHEAD=16,SEQ=2048,D=64,DM=1024;
constexpr int NW=8,QBLK=32,QB=QBLK*NW,KVBLK=64,NQB=SEQ/QB;
constexpr int ATTN_PITCH=DM, ATTN_UNIT_ROWS=QB;
__device__ __forceinline__ int crow(int r,int hi){return (r&3)+8*(r>>2)+4*hi;}
#define SBAR() __builtin_amdgcn_sched_barrier(0)
__device__ __forceinline__ void cmask(f32x16&p0,f32x16&p1,int jb,int qrel,int hi){
  const float NEG=-INFINITY; int kb=64*jb+4*hi;
  #pragma unroll
  for(int r=0;r<16;++r){int kv=kb+(r&3)+8*(r>>2); if(kv>qrel)p0[r]=NEG; if(kv+32>qrel)p1[r]=NEG;}
}

constexpr int NSLOT=3, SLOTB=8192;
constexpr int LDS_K=0, LDS_V=NSLOT*SLOTB, LDS_WS=2*NSLOT*SLOTB, LDS_OST=LDS_WS+NW*64*4, LDS_BYTES=LDS_OST+NW*4096;
constexpr float C2=0.125f*1.4426950408889634f;
__device__ __forceinline__ void glds16(const void*gsrc,unsigned lds_dst){unsigned keep;
  asm volatile("s_mov_b32 %0, m0\n\ts_mov_b32 m0, %2\n\ts_nop 0\n\tglobal_load_lds_dwordx4 %1, off\n\ts_mov_b32 m0, %0":"=&s"(keep):"v"(gsrc),"s"(lds_dst):"memory");}
__device__ __forceinline__ float max3f(float a,float b,float c){float r;asm("v_max3_f32 %0, %1, %2, %3":"=v"(r):"v"(a),"v"(b),"v"(c));return r;}
__device__ __forceinline__ float max2f(float a,float b){float r;asm("v_max_f32_e32 %0, %1, %2":"=v"(r):"v"(a),"v"(b));return r;}
__device__ __forceinline__ float fadd_s(float a,float b){float r;asm("v_add_f32_e32 %0, %1, %2":"=v"(r):"v"(a),"v"(b));return r;}
__device__ __forceinline__ float fsub_s(float a,float b){float r;asm("v_sub_f32_e32 %0, %1, %2":"=v"(r):"v"(a),"v"(b));return r;}
typedef float f32x2_t __attribute__((ext_vector_type(2))); typedef __bf16 bf16x2_t __attribute__((ext_vector_type(2)));
__device__ __forceinline__ unsigned cvtpk_s(float lo,float hi){f32x2_t v={lo,hi};bf16x2_t b=__builtin_convertvector(v,bf16x2_t);return __builtin_bit_cast(unsigned,b);}
#define WAIT_BAR(N) asm volatile("s_waitcnt vmcnt(" #N ") lgkmcnt(0)\n\ts_barrier":::"memory")

__device__ __forceinline__ void qkt(f32x16&p0,f32x16&p1,const char*Kslot,const bf16x8*qr,const f32x16&negm,int r32,int hi){
  const char*kb=Kslot+hi*1024+r32*16;
  #pragma unroll
  for(int d0=0;d0<4;++d0){
    const bf16x8 b0=*reinterpret_cast<const bf16x8*>(kb+d0*2048);
    const bf16x8 b1=*reinterpret_cast<const bf16x8*>(kb+d0*2048+512);
    if(d0==0){p0=__builtin_amdgcn_mfma_f32_32x32x16_bf16(b0,qr[0],negm,0,0,0);p1=__builtin_amdgcn_mfma_f32_32x32x16_bf16(b1,qr[0],negm,0,0,0);}
    else{p0=__builtin_amdgcn_mfma_f32_32x32x16_bf16(b0,qr[d0],p0,0,0,0);p1=__builtin_amdgcn_mfma_f32_32x32x16_bf16(b1,qr[d0],p1,0,0,0);}}
}
typedef __attribute__((address_space(3))) const char* lds_cptr;
typedef short v4i16_t __attribute__((ext_vector_type(4)));
__device__ __forceinline__ void kload8(bf16x8*kf,lds_cptr kp){
  kf[0]=*(const __attribute__((address_space(3))) bf16x8*)(kp);      kf[1]=*(const __attribute__((address_space(3))) bf16x8*)(kp+512);
  kf[2]=*(const __attribute__((address_space(3))) bf16x8*)(kp+2048); kf[3]=*(const __attribute__((address_space(3))) bf16x8*)(kp+2560);
  kf[4]=*(const __attribute__((address_space(3))) bf16x8*)(kp+4096); kf[5]=*(const __attribute__((address_space(3))) bf16x8*)(kp+4608);
  kf[6]=*(const __attribute__((address_space(3))) bf16x8*)(kp+6144); kf[7]=*(const __attribute__((address_space(3))) bf16x8*)(kp+6656);
}
__device__ __forceinline__ void kload2(bf16x8*kf,lds_cptr kp,int j){ kf[2*j]=*(const __attribute__((address_space(3))) bf16x8*)(kp+j*2048); kf[2*j+1]=*(const __attribute__((address_space(3))) bf16x8*)(kp+j*2048+512); }
__device__ __forceinline__ s16x4 vtr(lds_cptr p){ return __builtin_bit_cast(s16x4,__builtin_amdgcn_ds_read_tr16_b64_v4i16((__attribute__((address_space(3))) v4i16_t*)p)); }
__device__ __forceinline__ float rowmax(const f32x16&p0,const f32x16&p1){
  float a=max3f(p0[0],p0[1],p1[0]),b=max3f(p0[2],p0[3],p1[1]);a=max3f(a,p1[2],p1[3]);
  #pragma unroll
  for(int r=4;r<16;r+=4){a=max3f(a,p0[r],p0[r+1]);b=max3f(b,p0[r+2],p0[r+3]);a=max3f(a,p1[r],p1[r+1]);b=max3f(b,p1[r+2],p1[r+3]);}
  const float m=max2f(a,b);
  auto rr=__builtin_amdgcn_permlane32_swap(__float_as_uint(m),__float_as_uint(m),false,false);
  return max2f(__uint_as_float(rr[0]),__uint_as_float(rr[1]));
}
__device__ __forceinline__ void pv(f32x16*o,int vb,bf16x8 pa0,bf16x8 pa1,bf16x8 pa2,bf16x8 pa3){
  #pragma unroll
  for(int d0=0;d0<2;++d0){s16x4 lo[4],hi[4];
    #pragma unroll
    for(int ks=0;ks<4;++ks){
      asm volatile("ds_read_b64_tr_b16 %0,%1 offset:%c2":"=&v"(lo[ks]):"v"(vb),"i"(d0*4096+ks*1024):"memory");
      asm volatile("ds_read_b64_tr_b16 %0,%1 offset:%c2":"=&v"(hi[ks]):"v"(vb),"i"(d0*4096+ks*1024+512):"memory");}
    asm volatile("s_waitcnt lgkmcnt(0)":::"memory");SBAR();
    #define PK(k) (bf16x8){lo[k][0],lo[k][1],lo[k][2],lo[k][3],hi[k][0],hi[k][1],hi[k][2],hi[k][3]}
    o[d0]=__builtin_amdgcn_mfma_f32_32x32x16_bf16(pa0,PK(0),o[d0],0,0,0);
    o[d0]=__builtin_amdgcn_mfma_f32_32x32x16_bf16(pa1,PK(1),o[d0],0,0,0);
    o[d0]=__builtin_amdgcn_mfma_f32_32x32x16_bf16(pa2,PK(2),o[d0],0,0,0);
    o[d0]=__builtin_amdgcn_mfma_f32_32x32x16_bf16(pa3,PK(3),o[d0],0,0,0);
    #undef PK
  }
}

#ifndef ATTN_STORE16
#define ATTN_STORE16(p,v) (*(u32x4*)(p)=(v))
#endif
template<int THRL> __device__ __forceinline__ void attn_unit(int b,int qcol,int vcol,int qb,const bf16*Q,const bf16*__restrict__ K,const bf16*__restrict__ V,bf16*O,char*shm,bool comb,float lam){
  int tid_=threadIdx.x; asm volatile("":"+v"(tid_)); const int tid=tid_,lane=tid&63,r32=lane&31,hi=lane>>5; const int wid=__builtin_amdgcn_readfirstlane(tid>>6);
  const long rowbase=(long)b*SEQ; const int q0=qb*QB;
  const bf16*Qw=Q+(rowbase+q0+wid*QBLK)*DM+qcol;
  const bf16*Kh=K+rowbase*DM+qcol,*Vh=V+rowbase*DM+vcol;
  const unsigned lds0=(unsigned)(uintptr_t)shm;
  float*wsf=(float*)(shm+LDS_WS)+wid*64;
  const bf16*ksrc=Kh+(long)lane*DM+wid*8;
  const bf16*vsrc=Vh+(long)(16*(wid&3)+(lane>>2))*DM+(wid>>2)*32+(lane&3)*8;
  const unsigned kdst=lds0+LDS_K+wid*1024, vdst=lds0+LDS_V+wid*1024;
  #define DMA_K(t,slot) glds16(ksrc+(long)(t)*KVBLK*DM,(unsigned)__builtin_amdgcn_readfirstlane(kdst+(slot)))
  #define DMA_V(t,slot) glds16(vsrc+(long)(t)*KVBLK*DM,(unsigned)__builtin_amdgcn_readfirstlane(vdst+(slot)))
  const int vb0=(int)(lds0+LDS_V)+((lane>>4)&1)*32+(lane&3)*8+(4*hi+((lane&15)>>2))*64;
  const char*Kbase=shm+LDS_K; bf16x8 kf[8];
  const lds_cptr shm3=(lds_cptr)shm; const lds_cptr kp0=shm3+LDS_K+hi*1024+r32*16; const lds_cptr vp0=shm3+LDS_V+((lane>>4)&1)*32+(lane&3)*8+(4*hi+((lane&15)>>2))*64;
  const int NT=(q0+QB)/KVBLK;
  DMA_K(0,0);DMA_V(0,0);DMA_K(1,SLOTB);
  bf16x8 qr[4];
  #pragma unroll
  for(int d0=0;d0<4;++d0)qr[d0]=*reinterpret_cast<const bf16x8*>(&Qw[(long)r32*DM+d0*16+hi*8]);
  float mhat=0.f,l_reg=0.f;f32x16 o[2];o[0]=f32x16{};o[1]=f32x16{};f32x16 negm=f32x16{};asm volatile("":"+v"(negm));
  const int qrel=wid*QBLK+r32;
  #define CMASK(P0,P1,t) do{int jb_=(t)-(NT-4); if(jb_>=0)cmask(P0,P1,jb_,qrel,hi);}while(0)
  bool resc=false;
  #define START(P0,P1) do{ const float rm=rowmax(P0,P1); resc=false; \
    { const float dl=rm; mhat=fadd_s(mhat,dl); \
      _Pragma("unroll") for(int r=0;r<16;++r){P0[r]=fsub_s(P0[r],dl);P1[r]=fsub_s(P1[r],dl);} \
      _Pragma("unroll") for(int r=0;r<16;++r)negm[r]=-mhat; asm volatile("":"+v"(negm)); } \
    _Pragma("unroll") for(int r=0;r<16;++r)P0[r]=__builtin_amdgcn_exp2f(P0[r]); }while(0)
  #define RESC() do{ if(resc){ asm volatile("s_waitcnt lgkmcnt(0)":::"memory"); \
      _Pragma("unroll") for(int d_=0;d_<2;++d_) _Pragma("unroll") for(int r=0;r<16;++r)o[d_][r]*=wsf[crow(r,hi)]; } }while(0)
  f32x16 pA0,pA1,pB0,pB1;
  int sl_prev=0,sl_cur=0,sl_next=SLOTB;
  #define ROT() do{sl_prev=sl_cur;sl_cur=sl_next;sl_next=(sl_next==(NSLOT-1)*SLOTB)?0:sl_next+SLOTB;}while(0)
  DMA_K(2,2*SLOTB);
  WAIT_BAR(3);
  qkt(pA0,pA1,Kbase,qr,negm,r32,hi);asm volatile("s_nop 15\n\ts_nop 7":"+v"(pA0),"+v"(pA1));CMASK(pA0,pA1,0);
  START(pA0,pA1);
  _Pragma("unroll") for(int r=0;r<16;++r)pA1[r]=__builtin_amdgcn_exp2f(pA1[r]);
  WAIT_BAR(0);
  DMA_K(3,0);DMA_V(1,SLOTB);
  ROT();
  kload8(kf,kp0+sl_cur);
  WAIT_BAR(2);
  s16x4 vlo[8],vhi[8]; u32x4 pw0,pw1,pw2,pw3;
  #define PKW(P,B) cvtpk_s(P[B],P[B+1])
  #define PAF(k) __builtin_bit_cast(bf16x8,pw##k)
  #define VFR(i) (bf16x8){vlo[i][0],vlo[i][1],vlo[i][2],vlo[i][3],vhi[i][0],vhi[i][1],vhi[i][2],vhi[i][3]}
  #define PIN(x) asm volatile("":"+v"(x))
  #define MX3(a,b,c) __builtin_fmaxf(__builtin_fmaxf((a),(b)),(c))
  #define GAPA(MF,A0,A1,A2,A3,W0,W1,PW) do{ MF; sacc+=A0; sacc+=A1; sacc+=A2; sacc+=A3; PIN(sacc); W0; W1; PIN(PW); SBAR(); }while(0)
  #define EX(v) __builtin_amdgcn_exp2f(v)
  #define GAPB(MF,X,B) do{ MF; X[B]=EX(X[B]); X[B+1]=EX(X[B+1]); X[B+2]=EX(X[B+2]); X[B+3]=EX(X[B+3]); PIN(X); SBAR(); }while(0)
  #define VRD(i) do{ vlo[i]=vtr(vp_+(((i)>>2)*4096+((i)&3)*1024)); vhi[i]=vtr(vp_+(((i)>>2)*4096+((i)&3)*1024+512)); }while(0)
  #define KRD(G,j) do{ if(G){ kload2(kf,kp0+sl_next,j); SBAR(); } }while(0)
  #define STEP(C0,C1,P0,P1,t,GK,GV,GL) do{ SBAR(); \
    const lds_cptr vp_=vp0+sl_prev; \
    VRD(0); SBAR(); float sacc=(P0[0]+P0[1]); \
    GAPA(C0=__builtin_amdgcn_mfma_f32_32x32x16_bf16(kf[0],qr[0],negm,0,0,0), P0[2],P0[3],P0[4],P0[5],     pw0[0]=PKW(P0,0), pw0[1]=PKW(P0,2), pw0); \
    VRD(4); SBAR(); GAPA(C1=__builtin_amdgcn_mfma_f32_32x32x16_bf16(kf[1],qr[0],negm,0,0,0), P0[6],P0[7],P0[8],P0[9],     pw0[2]=PKW(P0,4), pw0[3]=PKW(P0,6), pw0); \
    VRD(1); SBAR(); GAPA(C0=__builtin_amdgcn_mfma_f32_32x32x16_bf16(kf[2],qr[1],C0,0,0,0),   P0[10],P0[11],P0[12],P0[13], pw1[0]=PKW(P0,8), pw1[1]=PKW(P0,10), pw1); \
    VRD(5); SBAR(); GAPA(C1=__builtin_amdgcn_mfma_f32_32x32x16_bf16(kf[3],qr[1],C1,0,0,0),   P0[14],P0[15],P1[0],P1[1],   pw1[2]=PKW(P0,12),pw1[3]=PKW(P0,14), pw1); \
    VRD(2); SBAR(); GAPA(C0=__builtin_amdgcn_mfma_f32_32x32x16_bf16(kf[4],qr[2],C0,0,0,0),   P1[2],P1[3],P1[4],P1[5],     pw2[0]=PKW(P1,0), pw2[1]=PKW(P1,2), pw2); \
    VRD(6); SBAR(); GAPA(C1=__builtin_amdgcn_mfma_f32_32x32x16_bf16(kf[5],qr[2],C1,0,0,0),   P1[6],P1[7],P1[8],P1[9],     pw2[2]=PKW(P1,4), pw2[3]=PKW(P1,6), pw2); \
    VRD(3); SBAR(); GAPA(C0=__builtin_amdgcn_mfma_f32_32x32x16_bf16(kf[6],qr[3],C0,0,0,0),   P1[10],P1[11],P1[12],P1[13], pw3[0]=PKW(P1,8), pw3[1]=PKW(P1,10), pw3); \
    VRD(7); SBAR(); GAPA(C1=__builtin_amdgcn_mfma_f32_32x32x16_bf16(kf[7],qr[3],C1,0,0,0),   P1[14],P1[15],0.f,0.f,       pw3[2]=PKW(P1,12),pw3[3]=PKW(P1,14), pw3); \
    l_reg+=sacc; \
    if(GK){DMA_K((t)+3,sl_cur);} if(GV){DMA_V((t)+1,sl_next);} \
    CMASK(C0,C1,t); \
    { float a=MX3(C0[0],C0[1],C1[0]),b=MX3(C0[2],C0[3],C1[1]); a=MX3(a,C1[2],C1[3]); \
      _Pragma("unroll") for(int r=4;r<16;r+=4){a=MX3(a,C0[r],C0[r+1]);b=MX3(b,C0[r+2],C0[r+3]);a=MX3(a,C1[r],C1[r+1]);b=MX3(b,C1[r+2],C1[r+3]);} \
      float rm=__builtin_fmaxf(a,b); { auto rr=__builtin_amdgcn_permlane32_swap(__float_as_uint(rm),__float_as_uint(rm),false,false); rm=__builtin_fmaxf(__uint_as_float(rr[0]),__uint_as_float(rr[1])); } \
      resc=false; \
      if(__builtin_expect(__any(rm>(float)THRL),0)){ const float dl=__builtin_fmaxf(rm,0.f); mhat+=dl; \
        _Pragma("unroll") for(int r=0;r<16;++r){C0[r]-=dl;C1[r]-=dl;} \
        _Pragma("unroll") for(int r=0;r<16;++r)negm[r]=-mhat; asm volatile("":"+v"(negm)); \
        const float f=__builtin_amdgcn_exp2f(-dl); l_reg*=f; if(hi==0)wsf[r32]=f; resc=true; } } \
    SBAR(); \
    GAPB(o[0]=__builtin_amdgcn_mfma_f32_32x32x16_bf16(PAF(0),VFR(0),o[0],0,0,0), C0,0); \
    GAPB(o[1]=__builtin_amdgcn_mfma_f32_32x32x16_bf16(PAF(0),VFR(4),o[1],0,0,0), C0,4); \
    KRD(GL,0); GAPB(o[0]=__builtin_amdgcn_mfma_f32_32x32x16_bf16(PAF(1),VFR(1),o[0],0,0,0), C0,8); \
    KRD(GL,1); GAPB(o[1]=__builtin_amdgcn_mfma_f32_32x32x16_bf16(PAF(1),VFR(5),o[1],0,0,0), C0,12); \
    KRD(GL,2); GAPB(o[0]=__builtin_amdgcn_mfma_f32_32x32x16_bf16(PAF(2),VFR(2),o[0],0,0,0), C1,0); \
    KRD(GL,3); GAPB(o[1]=__builtin_amdgcn_mfma_f32_32x32x16_bf16(PAF(2),VFR(6),o[1],0,0,0), C1,4); \
    GAPB(o[0]=__builtin_amdgcn_mfma_f32_32x32x16_bf16(PAF(3),VFR(3),o[0],0,0,0), C1,8); \
    GAPB(o[1]=__builtin_amdgcn_mfma_f32_32x32x16_bf16(PAF(3),VFR(7),o[1],0,0,0), C1,12); \
    }while(0)
  int t=1;
  #undef CMASK
  #define CMASK(P0,P1,t) do{}while(0)
  for(;t+5<NT;t+=2){
    STEP(pB0,pB1,pA0,pA1,t,true,true,true);     WAIT_BAR(2); RESC(); ROT();
    STEP(pA0,pA1,pB0,pB1,t+1,true,true,true);   WAIT_BAR(2); RESC(); ROT();
  }
  #undef CMASK
  #define CMASK(P0,P1,t) do{int jb_=(t)-(NT-4); if(jb_>=0)cmask(P0,P1,jb_,qrel,hi);}while(0)
  #define ENDW(tt) do{ if((tt)+3<NT){WAIT_BAR(2);} else if((tt)+2<NT){WAIT_BAR(1);} else {WAIT_BAR(0);} }while(0)
  for(;t+1<NT;t+=2){
    STEP(pB0,pB1,pA0,pA1,t,(t+3<NT),(t+1<NT),(t+1<NT));       ENDW(t);   RESC(); ROT();
    STEP(pA0,pA1,pB0,pB1,t+1,(t+4<NT),(t+2<NT),(t+2<NT));     ENDW(t+1); RESC(); ROT();
  }
  STEP(pB0,pB1,pA0,pA1,NT-1,false,false,false); RESC();
  { float sacc=pB0[0]+pB0[1]; _Pragma("unroll") for(int r=2;r<16;++r)sacc+=pB0[r]; _Pragma("unroll") for(int r=0;r<16;++r)sacc+=pB1[r]; l_reg+=sacc;
    pw0=(u32x4){PKW(pB0,0),PKW(pB0,2),PKW(pB0,4),PKW(pB0,6)};pw1=(u32x4){PKW(pB0,8),PKW(pB0,10),PKW(pB0,12),PKW(pB0,14)};pw2=(u32x4){PKW(pB1,0),PKW(pB1,2),PKW(pB1,4),PKW(pB1,6)};pw3=(u32x4){PKW(pB1,8),PKW(pB1,10),PKW(pB1,12),PKW(pB1,14)};
    SBAR(); pv(o,vb0+sl_cur,PAF(0),PAF(1),PAF(2),PAF(3)); }
  #undef PKW
  #undef PAF
  #undef VFR
  #undef PIN
  #undef MX3
  #undef GAPA
  #undef GAPB
  #undef EX
  #undef VRD
  #undef KRD
  #undef STEP
  #undef ENDW
  {auto rr=__builtin_amdgcn_permlane32_swap(__float_as_uint(l_reg),__float_as_uint(l_reg),false,false);l_reg=__uint_as_float(rr[0])+__uint_as_float(rr[1]);}
  if(hi==0)wsf[32+r32]=l_reg;asm volatile("s_waitcnt lgkmcnt(0)":::"memory");
  float rli[16];
  #pragma unroll
  for(int r=0;r<16;++r)rli[r]=__builtin_amdgcn_rcpf(wsf[32+crow(r,hi)]);
  bf16*Ow=O+(rowbase+q0+wid*QBLK)*DM+vcol;
  { bf16*stg=(bf16*)(shm+LDS_OST)+wid*2048;
    #pragma unroll
    for(int r=0;r<16;++r){const int orow=crow(r,hi);
      #pragma unroll
      for(int d0=0;d0<2;++d0)stg[orow*64+d0*32+r32]=__float2bfloat16(o[d0][r]*rli[r]);}
    asm volatile("s_waitcnt lgkmcnt(0)":::"memory");
    #pragma unroll
    for(int i=0;i<4;++i){const int row=i*8+(lane>>3),ch=lane&7; u32x4 v=*(const u32x4*)(stg+row*64+ch*8);
      if(comb){ const u32x4 w=*(const u32x4*)(Ow+(long)row*DM+ch*8); u32x4 o_;
        #pragma unroll
        for(int e=0;e<4;++e){ const float a0=__uint_as_float(w[e]<<16),a1=__uint_as_float(w[e]&0xffff0000u),b0=__uint_as_float(v[e]<<16),b1=__uint_as_float(v[e]&0xffff0000u);
          o_[e]=cvtpk_s(a0-lam*b0,a1-lam*b1);} v=o_; }
      ATTN_STORE16(Ow+(long)row*DM+ch*8,v);} }
  asm volatile("s_waitcnt lgkmcnt(0)\n\ts_barrier":::"memory");
  #undef DMA_K
  #undef DMA_V
  #undef CMASK
  #undef START
  #undef RESC
  #undef ROT
}
constexpr int ATTN_LDS_BYTES=LDS_BYTES;
#undef SBAR
#undef WAIT_BAR
}
#define LAS __attribute__((address_space(3)))
typedef unsigned short bf16;
typedef unsigned v4u __attribute__((ext_vector_type(4)));
typedef unsigned v2u __attribute__((ext_vector_type(2)));
typedef float f32x4 __attribute__((ext_vector_type(4)));
typedef float f32x16 __attribute__((ext_vector_type(16)));
typedef short bf16x8 __attribute__((ext_vector_type(8)));
typedef short s16x4 __attribute__((ext_vector_type(4)));

constexpr int NWAVES = 8, NTHR = 512;
constexpr int BATCH = 16, SEQ = 2048, D = 1024, T = BATCH * SEQ, MEMLEN = 256, TM = BATCH * MEMLEN, FF = 2816, INDIM = 8200;
constexpr float LN_EPS = 1e-5f;
constexpr float ALPHA = 1.189207115002721f;
constexpr float LOG2E = 1.4426950408889634f;
constexpr int LDS_BYTES = 147456;

constexpr size_t MiB = 1u << 20;
constexpr size_t WS_WIN1 = 0, WS_WIN2 = 10 * MiB, WS_WSQ = 16 * MiB  , WS_WGU = 30 * MiB, WS_WDN = 41 * MiB;
constexpr size_t WS_IFG = 47 * MiB, WS_COS = 48 * MiB, WS_SIN = 52 * MiB, WS_SCT = 56 * MiB, WS_CHK = 58 * MiB, WS_MPREV = 59 * MiB, WS_CTL = 59 * MiB + 512 * 1024, CTL_BYTES = 16384;
constexpr size_t WS_MEMB = 60 * MiB, WS_XK = 68 * MiB, WS_XVT = 76 * MiB;
constexpr size_t WS_S0 = 84 * MiB, WS_S1 = 148 * MiB, WS_S2 = 212 * MiB, WS_S3 = 276 * MiB, WS_S4 = 340 * MiB, WS_S5 = 404 * MiB, WS_END = 468 * MiB;

__device__ __forceinline__ unsigned f2bf(float f) { unsigned u = __builtin_bit_cast(unsigned, f); return (u + 0x7fffu + ((u >> 16) & 1u)) >> 16; }
__device__ __forceinline__ unsigned pk2(float lo, float hi) { return pg8::cvt_pk_bf16(lo, hi); }
__device__ __forceinline__ float bflo(unsigned w) { return __uint_as_float(w << 16); }
__device__ __forceinline__ float bfhi(unsigned w) { return __uint_as_float(w & 0xffff0000u); }
__device__ __forceinline__ float wave_sum(float v) {
#pragma unroll
    for (int o = 1; o < 64; o <<= 1) v += __shfl_xor(v, o);
    return v;
}
#define LDS_WAIT() asm volatile("s_waitcnt lgkmcnt(0)" ::: "memory")

#define XB_TMO      128
#define XB_XCNT(j)  (256  + 64 * (j))
#define XB_XSUB(j)  (1280 + 64 * (j))
#define XB_XGEN(j)  (2304 + 64 * (j))
#define XB_TOP      3328
#define XB_TOPGEN   3392
#define XCD_BAR_WORDS 3456
#define XB_SPIN_CAP (1u << 18)

__device__ __forceinline__ unsigned xb_ld(unsigned* p)              { return __hip_atomic_load(p, __ATOMIC_RELAXED, __HIP_MEMORY_SCOPE_AGENT); }
__device__ __forceinline__ unsigned xb_add(unsigned* p, unsigned v) { return __hip_atomic_fetch_add(p, v, __ATOMIC_RELAXED, __HIP_MEMORY_SCOPE_AGENT); }
__device__ __forceinline__ unsigned xb_xcc_id() { return (unsigned)__builtin_amdgcn_s_getreg((3 << 11) | 20) & 0xFu; }
#define XB_SPIN(cond, bar) do { unsigned _sp = 0; while (cond) { __builtin_amdgcn_s_sleep(1); \
    if ((++_sp & 255u) == 0u) { if (xb_ld(&(bar)[XB_TMO])) break; if (_sp > XB_SPIN_CAP) { atomicAdd(&(bar)[XB_TMO], 1u); break; } } } } while (0)

struct XcdBarrier {
    unsigned* bar; unsigned x;
    volatile LAS unsigned* st;
};

__device__ __forceinline__ XcdBarrier xcd_barrier_post(unsigned* bar, volatile LAS unsigned* st) {
    XcdBarrier b; b.bar = bar; b.x = xb_xcc_id(); b.st = st;
    if (threadIdx.x == 0) (void)xb_add(&bar[XB_XCNT(b.x)], 1u);
    return b;
}
__device__ __forceinline__ void xcd_barrier_complete(unsigned* bar, unsigned x, unsigned& nloc, unsigned& nx) {
    const unsigned G = gridDim.x * gridDim.y * gridDim.z;
    unsigned sum, cnt, mine, sp = 0u;
    for (;;) {
        sum = 0u; cnt = 0u; mine = 0u;
#pragma unroll
        for (unsigned j = 0; j < 16; ++j) { const unsigned c = xb_ld(&bar[XB_XCNT(j)]); sum += c; cnt += (c > 0u) ? 1u : 0u; mine = (j == x) ? c : mine; }
        if (sum == G) break;
        __builtin_amdgcn_s_sleep(1);
        if ((++sp & 255u) == 0u) { if (xb_ld(&bar[XB_TMO])) break; if (sp > XB_SPIN_CAP) { atomicAdd(&bar[XB_TMO], 1u); break; } }
    }
    nloc = mine > 0u ? mine : 1u; nx = cnt > 0u ? cnt : 1u;
}

__device__ __forceinline__ void xcd_barrier(const XcdBarrier& b) {
    asm volatile("s_waitcnt vmcnt(0)" ::: "memory");
    __syncthreads();
    if (threadIdx.x == 0) {
        unsigned* bar = b.bar;
        __builtin_amdgcn_s_waitcnt(0);
        unsigned nloc = b.st[0], nx = b.st[1];
        if (nloc == 0u) { xcd_barrier_complete(bar, b.x, nloc, nx); b.st[0] = nloc; b.st[1] = nx; }
        const unsigned old = xb_add(&bar[XB_XSUB(b.x)], 1u);
        const unsigned gen = old / nloc;
        if (old + 1u == (gen + 1u) * nloc) {
            __builtin_amdgcn_fence(__ATOMIC_RELEASE, "agent");
            asm volatile("s_waitcnt vmcnt(0)" ::: "memory");
            const unsigned og = xb_add(&bar[XB_TOP], 1u);
            const unsigned tg = og / nx;
            if (og + 1u == (tg + 1u) * nx) xb_add(&bar[XB_TOPGEN], 1u);
            else XB_SPIN(xb_ld(&bar[XB_TOPGEN]) == tg, bar);
            __builtin_amdgcn_fence(__ATOMIC_ACQUIRE, "agent");
            xb_add(&bar[XB_XGEN(b.x)], 1u);
            asm volatile("s_waitcnt vmcnt(0)" ::: "memory");
        } else {
            XB_SPIN(xb_ld(&bar[XB_XGEN(b.x)]) == gen, bar);
            __builtin_amdgcn_fence(__ATOMIC_ACQUIRE, "agent");
            asm volatile("s_waitcnt vmcnt(0)" ::: "memory");
        }
    }
    __syncthreads();
}


__device__ __forceinline__ void transpose_item(const float* W, int ldw, int k0, int sc0, bf16* WT, int ldt, int dr0, LAS float* scr, int lane) {
#pragma unroll 8
    for (int i = 0; i < 32; ++i) { const int kk = 2 * i + (lane >> 5); scr[kk * 33 + (lane & 31)] = W[(size_t)(k0 + kk) * ldw + sc0 + (lane & 31)]; }
    LDS_WAIT(); asm volatile("" ::: "memory");
    const int c = lane & 7;
#pragma unroll
    for (int j = 0; j < 4; ++j) { const int n = (lane >> 3) + 8 * j; const LAS float* s = scr + (8 * c) * 33 + n;
        v4u o; o.x = pk2(s[0 * 33], s[1 * 33]); o.y = pk2(s[2 * 33], s[3 * 33]); o.z = pk2(s[4 * 33], s[5 * 33]); o.w = pk2(s[6 * 33], s[7 * 33]);
        *(v4u*)(WT + (size_t)(dr0 + n) * ldt + k0 + 8 * c) = o; }
    LDS_WAIT(); asm volatile("" ::: "memory");
}

struct Ptrs {
    const float* x; const float* mem; const int* pos; const float* w_in; const float* b_in; const float* conv_w; const float* conv_b; const float* ml_norm_w;
    const float *lq1, *lk1, *lq2, *lk2; const float* da_norm_w; const float* wsq[7];
    const float *ln1g, *ln1b, *ln2g, *ln2b, *ln3g, *ln3b; const float *w_gate, *w_up, *w_down;
    float* out; unsigned char* ws;
};

__device__ __forceinline__ void p0_prologue(const Ptrs& P, LAS unsigned char* lds, int gw, int NGW, int wave, int lane, int tid) {
    unsigned char* ws = P.ws;
    LAS float* scr = (LAS float*)(lds + 32768 + wave * 8704);
    constexpr int I0 = 16 * 160, I1 = 16 * 96, I2 = 7 * 512, I3 = 16 * 176, I4 = 44 * 32, NIT = I0 + I1 + I2 + I3 + I4;
    for (int it = gw; it < NIT; it += NGW) {
        int r = it;
        if (r < I0) { const int kb = r / 160, nb = r % 160, d0 = 32 * nb; int sc0;
            if (d0 < 2048) sc0 = d0;
            else if (d0 < 4096) { const int isk = d0 >= 3072, local = d0 - (isk ? 3072 : 2048), tile = local >> 8, p = local & 255, half = p >> 7, head = (p & 127) >> 5;
                sc0 = (isk ? 4104 : 3080) + tile * 256 + head * 64 + half * 32; }
            else sc0 = 5128 + (d0 - 4096);
            transpose_item(P.w_in, INDIM, 64 * kb, sc0, (bf16*)(ws + WS_WIN1), 1024, d0, scr, lane); continue; }
        r -= I0;
        if (r < I1) { const int kb = r / 96, nb = r % 96, d0 = 32 * nb; const int sc0 = d0 < 1024 ? 2048 + d0 : 6152 + (d0 - 1024);
            transpose_item(P.w_in, INDIM, 64 * kb, sc0, (bf16*)(ws + WS_WIN2), 1024, d0, scr, lane); continue; }
        r -= I1;
        if (r < I2) { const int j = r >> 9, q = r & 511, kb = q >> 5, nb = q & 31;
            const float* src = j == 0 ? P.wsq[0] : j == 1 ? P.wsq[1] : j == 2 ? P.wsq[2] : j == 3 ? P.wsq[3] : j == 4 ? P.wsq[4] : j == 5 ? P.wsq[5] : P.wsq[6];
            transpose_item(src, 1024, 64 * kb, 32 * nb, (bf16*)(ws + WS_WSQ + (size_t)j * 2 * MiB), 1024, 32 * nb, scr, lane); continue; }
        r -= I2;
        if (r < I3) { const int kb = r / 176, nb = r % 176, d0 = 32 * nb, tile = d0 >> 8, p = d0 & 255;
            const float* src = p < 128 ? P.w_gate : P.w_up; const int sc0 = tile * 128 + (p & 127);
            transpose_item(src, FF, 64 * kb, sc0, (bf16*)(ws + WS_WGU), 1024, d0, scr, lane); continue; }
        r -= I3;
        { const int kb = r >> 5, nb = r & 31; transpose_item(P.w_down, 1024, 64 * kb, 32 * nb, (bf16*)(ws + WS_WDN), FF, 32 * nb, scr, lane); }
    }
    LAS float* wif = (LAS float*)lds;
    for (int i = tid; i < 2048; i += NTHR) { const int k = i >> 1, hf = i & 1; const f32x4 v = *(const f32x4*)(P.w_in + (size_t)k * INDIM + 3072 + 4 * hf); *(LAS f32x4*)(wif + k * 8 + 4 * hf) = v; }
    __syncthreads();
    {
        bf16* XB = (bf16*)(ws + WS_S0); float* IFG = (float*)(ws + WS_IFG);
        float bi = P.b_in[3072 + (lane & 7)];
        for (int m = gw; m < T; m += NGW) {
            const f32x4* xr = (const f32x4*)(P.x + (size_t)m * D) + lane;
            f32x4 v[4];
#pragma unroll
            for (int j = 0; j < 4; ++j) v[j] = xr[64 * j];
            unsigned long long* o8 = (unsigned long long*)(XB + (size_t)m * D) + lane;
#pragma unroll
            for (int j = 0; j < 4; ++j) o8[64 * j] = (unsigned long long)pk2(v[j].x, v[j].y) | ((unsigned long long)pk2(v[j].z, v[j].w) << 32);
            float a[8];
#pragma unroll
            for (int o = 0; o < 8; ++o) a[o] = 0.f;
#pragma unroll
            for (int j = 0; j < 4; ++j)
#pragma unroll
                for (int e = 0; e < 4; ++e) { const int k = 4 * lane + 256 * j + e; const f32x4 w0 = *(LAS f32x4*)(wif + k * 8), w1 = *(LAS f32x4*)(wif + k * 8 + 4); const float xv = v[j][e];
                    a[0] += xv * w0.x; a[1] += xv * w0.y; a[2] += xv * w0.z; a[3] += xv * w0.w; a[4] += xv * w1.x; a[5] += xv * w1.y; a[6] += xv * w1.z; a[7] += xv * w1.w; }
#pragma unroll
            for (int o = 0; o < 8; ++o) a[o] = wave_sum(a[o]);
            float r = a[0];
#pragma unroll
            for (int o = 1; o < 8; ++o) r = ((lane & 7) == o) ? a[o] : r;
            if (lane < 8) IFG[(size_t)m * 8 + lane] = r + bi;
        }
    }
    {
        bf16* MB = (bf16*)(ws + WS_MEMB); const int gt = gw * 64 + lane, NGT = NGW * 64;
        for (int i = gt; i < TM * D / 8; i += NGT) { const f32x4 a = *(const f32x4*)(P.mem + (size_t)i * 8), b = *(const f32x4*)(P.mem + (size_t)i * 8 + 4);
            v4u o; o.x = pk2(a.x, a.y); o.y = pk2(a.z, a.w); o.z = pk2(b.x, b.y); o.w = pk2(b.z, b.w); *(v4u*)(MB + (size_t)i * 8) = o; }
        float* COS = (float*)(ws + WS_COS); float* SIN = (float*)(ws + WS_SIN);
        for (int i = gt; i < T * 32; i += NGT) { const int t = i >> 5, j = i & 31;
            const float inv = (float)exp2(-(double)j * (13.287712379549449 / 32.0));
            const float ang = (float)P.pos[t] * inv;
            const double rev = (double)ang * 0.15915494309189535; const double fr = rev - floor(rev);
            const float f = (float)fr;
            COS[i] = __builtin_amdgcn_cosf(f); SIN[i] = __builtin_amdgcn_sinf(f); }
    }
}

__device__ __forceinline__ void scan_step_a(unsigned char* ws, int gw, int NGW, int lane) {
    const float* IFG = (const float*)(ws + WS_IFG); f32x4* SCT = (f32x4*)(ws + WS_SCT); float* CHK = (float*)(ws + WS_CHK);
    for (int item = gw; item < 64 * 32; item += NGW) {
        const int bh = item >> 5, c = item & 31, b = bh >> 2, h = bh & 3; const size_t t = (size_t)b * SEQ + c * 64 + lane;
        const float iv = IFG[t * 8 + h], fv = IFG[t * 8 + 4 + h];
        const float lf = fminf(fv, 0.f) - __logf(1.0f + __expf(-fabsf(fv)));
        float bc = lf;
#pragma unroll
        for (int o = 1; o < 64; o <<= 1) { const float u = __shfl_up(bc, o); if (lane >= o) bc += u; }
        const float a = iv - bc; float pm = a;
#pragma unroll
        for (int o = 1; o < 64; o <<= 1) { const float u = __shfl_up(pm, o); if (lane >= o) pm = fmaxf(pm, u); }
        SCT[(size_t)bh * SEQ + c * 64 + lane] = (f32x4){a, pm, bc, 0.f};
        if (lane == 63) { CHK[(bh * 32 + c) * 2] = bc; CHK[(bh * 32 + c) * 2 + 1] = pm; }
    }
}
__device__ __forceinline__ void scan_step_b(unsigned char* ws, int tid) {
    if (blockIdx.x == 0 && tid < 64) { const float* CHK = (const float*)(ws + WS_CHK); float* MP = (float*)(ws + WS_MPREV); float m = 0.f;
        for (int c = 0; c < 32; ++c) { MP[tid * 32 + c] = m; const float bl = CHK[(tid * 32 + c) * 2], px = CHK[(tid * 32 + c) * 2 + 1]; m = bl + fmaxf(m, px); } }
}

__device__ __forceinline__ void conv_pass(const Ptrs& P, const bf16* QKRAW, bf16* MQ, bf16* MK, int gt, int NGT) {
    for (int idx = gt; idx < T * 128; idx += NGT) {
        const int t = idx >> 7, g = idx & 127, c0 = 8 * g, s = t & (SEQ - 1);
        float acc[8];
        { const f32x4 b0 = *(const f32x4*)(P.conv_b + c0), b1 = *(const f32x4*)(P.conv_b + c0 + 4); acc[0] = b0.x; acc[1] = b0.y; acc[2] = b0.z; acc[3] = b0.w; acc[4] = b1.x; acc[5] = b1.y; acc[6] = b1.z; acc[7] = b1.w; }
#pragma unroll
        for (int j = 0; j < 4; ++j) { if (s - 3 + j >= 0) {
            const v4u xv = *(const v4u*)(QKRAW + (size_t)(t - 3 + j) * 1024 + c0);
            const f32x4 w0 = *(const f32x4*)(P.conv_w + j * 1024 + c0), w1 = *(const f32x4*)(P.conv_w + j * 1024 + c0 + 4);
            acc[0] += bflo(xv.x) * w0.x; acc[1] += bfhi(xv.x) * w0.y; acc[2] += bflo(xv.y) * w0.z; acc[3] += bfhi(xv.y) * w0.w;
            acc[4] += bflo(xv.z) * w1.x; acc[5] += bfhi(xv.z) * w1.y; acc[6] += bflo(xv.w) * w1.z; acc[7] += bfhi(xv.w) * w1.w; } }
        const float sc = c0 < 512 ? 0.08838834764831845f : 1.0f;
#pragma unroll
        for (int e = 0; e < 8; ++e) acc[e] = acc[e] * pg8::fsigmoid(acc[e]) * sc;
        v4u o; o.x = pk2(acc[0], acc[1]); o.y = pk2(acc[2], acc[3]); o.z = pk2(acc[4], acc[5]); o.w = pk2(acc[6], acc[7]);
        if (c0 < 512) *(v4u*)(MQ + (size_t)t * 512 + c0) = o; else *(v4u*)(MK + (size_t)t * 512 + c0 - 512) = o;
    }
}

constexpr int ML_QS = 0, ML_KS = 17408, ML_KT = 34816, ML_VT = 53248, ML_PS = 64768, ML_CT = 73984, ML_TB = 95744;
#define MFMA16(a, b, c) __builtin_amdgcn_mfma_f32_16x16x32_bf16((a), (b), (c), 0, 0, 0)
__device__ __forceinline__ void mlstm_item(LAS unsigned char* lds, int b, int h, int dvs, const bf16* MQ, const bf16* MK, const bf16* MLV, const f32x4* SCT, const float* CHK, const float* MPREV, bf16* HML,
                                           int tid, int wid, int lane) {
    const int fr = lane & 15, fq = lane >> 4, rb = wid & 3, half = wid >> 2, bh = b * 4 + h;
    LAS float* TA = (LAS float*)(lds + ML_TB); LAS float* TMx = TA + 64; LAS float* TE = TA + 128; LAS float* TW = TA + 192; LAS float* DEN = TA + 256;
    for (int i = tid; i < 80 * 136 / 2; i += NTHR) ((LAS unsigned*)(lds + ML_CT))[i] = 0u;
    for (int i = tid; i < 16 * 72 / 2; i += NTHR) ((LAS unsigned*)(lds + ML_VT + 64 * 144))[i] = (i < 36) ? 0x3F803F80u : 0u;
    f32x4 cacc[5];
#pragma unroll
    for (int i = 0; i < 5; ++i) cacc[i] = (f32x4){0.f, 0.f, 0.f, 0.f};
    const int srow = tid >> 3, seg = tid & 7;
    const size_t tok0 = (size_t)b * SEQ;
    const bf16* qsrc = MQ + (tok0 + srow) * 512 + h * 128 + seg * 8;
    const bf16* ksrc = MK + (tok0 + srow) * 512 + h * 128 + seg * 8;
    const bf16* vsrc = MLV + (tok0 + srow) * 1024 + h * 256 + dvs * 64 + seg * 8;
    const f32x4* sct = SCT + (size_t)bh * SEQ;
    v4u q0, q1, k0, k1, v0; f32x4 scr_, sct_; float mprev, pmx;
#define ML_PREFETCH(c) do { const size_t o_ = (size_t)(c) * 64; q0 = *(const v4u*)(qsrc + o_ * 512); q1 = *(const v4u*)(qsrc + o_ * 512 + 64); k0 = *(const v4u*)(ksrc + o_ * 512); k1 = *(const v4u*)(ksrc + o_ * 512 + 64); \
        v0 = *(const v4u*)(vsrc + o_ * 1024); scr_ = sct[o_ + srow]; sct_ = sct[o_ + (tid & 63)]; mprev = MPREV[bh * 32 + (c)]; pmx = CHK[(bh * 32 + (c)) * 2 + 1]; } while (0)
    ML_PREFETCH(0);
    for (int c = 0; c < 32; ++c) {
        const float m63 = fmaxf(mprev, pmx), decay = __expf(mprev - m63), mp = mprev;
        if (tid < 64) { const float Mt = fmaxf(mp, sct_.y); TA[tid] = sct_.x; TMx[tid] = Mt; TE[tid] = __expf(-(sct_.z + Mt)); TW[tid] = __expf(mp - Mt); }
        const float wsr = __expf(scr_.x - m63);
        *(LAS v4u*)(lds + ML_QS + srow * 272 + seg * 16) = q0; *(LAS v4u*)(lds + ML_QS + srow * 272 + 128 + seg * 16) = q1;
        *(LAS v4u*)(lds + ML_KS + srow * 272 + seg * 16) = k0; *(LAS v4u*)(lds + ML_KS + srow * 272 + 128 + seg * 16) = k1;
        {
            LAS bf16* kt = (LAS bf16*)(lds + ML_KT); LAS bf16* vt = (LAS bf16*)(lds + ML_VT);
            const unsigned kk[8] = {k0.x, k0.y, k0.z, k0.w, k1.x, k1.y, k1.z, k1.w}; const unsigned vv[4] = {v0.x, v0.y, v0.z, v0.w};
#pragma unroll
            for (int e = 0; e < 4; ++e) {
                kt[(seg * 8 + 2 * e) * 72 + srow] = (bf16)f2bf(bflo(kk[e]) * wsr); kt[(seg * 8 + 2 * e + 1) * 72 + srow] = (bf16)f2bf(bfhi(kk[e]) * wsr);
                kt[(64 + seg * 8 + 2 * e) * 72 + srow] = (bf16)f2bf(bflo(kk[4 + e]) * wsr); kt[(64 + seg * 8 + 2 * e + 1) * 72 + srow] = (bf16)f2bf(bfhi(kk[4 + e]) * wsr);
                vt[(seg * 8 + 2 * e) * 72 + srow] = (bf16)(vv[e] & 0xffffu); vt[(seg * 8 + 2 * e + 1) * 72 + srow] = (bf16)(vv[e] >> 16); }
        }
        if (c + 1 < 32) ML_PREFETCH(c + 1);
        __syncthreads();
        bf16x8 qa[4];
#pragma unroll
        for (int ks = 0; ks < 4; ++ks) qa[ks] = *(const LAS bf16x8*)(lds + ML_QS + (16 * rb + fr) * 272 + ks * 64 + fq * 16);
        float tm[4], tw[4], te[4];
#pragma unroll
        for (int j = 0; j < 4; ++j) { const int t = 16 * rb + 4 * fq + j; tm[j] = TMx[t]; tw[j] = TW[t]; te[j] = TE[t]; }
#pragma unroll
        for (int ci = 0; ci < 2; ++ci) { const int cb = 2 * half + ci; f32x4 s = (f32x4){0.f, 0.f, 0.f, 0.f};
#pragma unroll
            for (int ks = 0; ks < 4; ++ks) { const bf16x8 kf = *(const LAS bf16x8*)(lds + ML_KS + (16 * cb + fr) * 272 + ks * 64 + fq * 16); s = MFMA16(qa[ks], kf, s); }
            const int sc = 16 * cb + fr; const float as = TA[sc];
#pragma unroll
            for (int j = 0; j < 4; ++j) { const int t = 16 * rb + 4 * fq + j; const float w = (sc <= t) ? __expf(as - tm[j]) : 0.f;
                ((LAS bf16*)(lds + ML_PS))[t * 72 + sc] = (bf16)f2bf(s[j] * w); } }
        f32x4 hacc[3];
#pragma unroll
        for (int i = 0; i < 3; ++i) { hacc[i] = (f32x4){0.f, 0.f, 0.f, 0.f};
            if (i < (half ? 2 : 3)) { const int nb = half ? 3 + i : i;
#pragma unroll
                for (int ks = 0; ks < 4; ++ks) { const bf16x8 cf = *(const LAS bf16x8*)(lds + ML_CT + (16 * nb + fr) * 272 + ks * 64 + fq * 16); hacc[i] = MFMA16(qa[ks], cf, hacc[i]); }
#pragma unroll
                for (int j = 0; j < 4; ++j) hacc[i][j] *= tw[j];
#if defined(DIAG) && DIAG == 5
                hacc[i] = (f32x4){0.f, 0.f, 0.f, 0.f};
#endif
                } }
        __syncthreads();
        {
            bf16x8 pa[2];
#pragma unroll
            for (int ks = 0; ks < 2; ++ks) pa[ks] = *(const LAS bf16x8*)(lds + ML_PS + (16 * rb + fr) * 144 + ks * 64 + fq * 16);
#pragma unroll
            for (int i = 0; i < 3; ++i) if (i < (half ? 2 : 3)) { const int nb = half ? 3 + i : i;
#pragma unroll
                for (int ks = 0; ks < 2; ++ks) { const bf16x8 vf = *(const LAS bf16x8*)(lds + ML_VT + (16 * nb + fr) * 144 + ks * 64 + fq * 16); hacc[i] = MFMA16(pa[ks], vf, hacc[i]); } }
            if (half == 1 && fr == 0) {
#pragma unroll
                for (int j = 0; j < 4; ++j) DEN[16 * rb + 4 * fq + j] = hacc[1][j]; }
            bf16x8 kf[2];
#pragma unroll
            for (int ks = 0; ks < 2; ++ks) kf[ks] = *(const LAS bf16x8*)(lds + ML_KT + (16 * wid + fr) * 144 + ks * 64 + fq * 16);
#pragma unroll
            for (int nb = 0; nb < 5; ++nb) { cacc[nb] = cacc[nb] * decay;
#pragma unroll
                for (int ks = 0; ks < 2; ++ks) { const bf16x8 vf = *(const LAS bf16x8*)(lds + ML_VT + (16 * nb + fr) * 144 + ks * 64 + fq * 16); cacc[nb] = MFMA16(vf, kf[ks], cacc[nb]); }
#pragma unroll
                for (int j = 0; j < 4; ++j) ((LAS bf16*)(lds + ML_CT))[(16 * nb + 4 * fq + j) * 136 + 16 * wid + fr] = (bf16)f2bf(cacc[nb][j]); }
        }
        __syncthreads();
        {
            float rd[4];
#pragma unroll
            for (int j = 0; j < 4; ++j) rd[j] = 1.0f / fmaxf(fabsf(DEN[16 * rb + 4 * fq + j]), te[j]);
#pragma unroll
            for (int i = 0; i < 3; ++i) { const int nb = half ? 3 + i : i; if (i < (half ? 1 : 3)) {
#pragma unroll
                for (int j = 0; j < 4; ++j) HML[(tok0 + c * 64 + 16 * rb + 4 * fq + j) * 1024 + h * 256 + dvs * 64 + 16 * nb + fr] = (bf16)f2bf(hacc[i][j] * rd[j]); } }
        }
    }
    __syncthreads();
#undef ML_PREFETCH
}


#if defined(DIAG) && DIAG == 6
__device__ __forceinline__ void mlstm_brute(LAS unsigned char* lds, int b, int h, int dvs, const bf16* MQ, const bf16* MK, const bf16* MLV, const float* IFG, bf16* HML, int tid) {
    const int dv = tid & 63, kg = tid >> 6;
    LAS float* part = (LAS float*)lds;
    LAS float* partd = part + 512;
    float C[16], n[16];
#pragma unroll
    for (int e = 0; e < 16; ++e) { C[e] = 0.f; n[e] = 0.f; }
    float m = 0.f;
    for (int t = 0; t < SEQ; ++t) {
        const size_t tok = (size_t)b * SEQ + t;
        const float iv = IFG[tok * 8 + h], fv = IFG[tok * 8 + 4 + h];
        const float lf = fminf(fv, 0.f) - log1pf(expf(-fabsf(fv)));
        const float mn = fmaxf(lf + m, iv), dec = expf(lf + m - mn), wi = expf(iv - mn); m = mn;
        const v4u k0 = *(const v4u*)(MK + tok * 512 + h * 128 + kg * 16), k1 = *(const v4u*)(MK + tok * 512 + h * 128 + kg * 16 + 8);
        const v4u q0 = *(const v4u*)(MQ + tok * 512 + h * 128 + kg * 16), q1 = *(const v4u*)(MQ + tok * 512 + h * 128 + kg * 16 + 8);
        const unsigned kr[8] = {k0.x, k0.y, k0.z, k0.w, k1.x, k1.y, k1.z, k1.w}, qr[8] = {q0.x, q0.y, q0.z, q0.w, q1.x, q1.y, q1.z, q1.w};
        const unsigned short vr = MLV[tok * 1024 + h * 256 + dvs * 64 + dv]; const float vv = __uint_as_float((unsigned)vr << 16);
        float num = 0.f, den = 0.f;
#pragma unroll
        for (int e = 0; e < 8; ++e) { const float ka = bflo(kr[e]), kb = bfhi(kr[e]), qa = bflo(qr[e]), qb = bfhi(qr[e]);
            C[2 * e] = dec * C[2 * e] + wi * ka * vv; C[2 * e + 1] = dec * C[2 * e + 1] + wi * kb * vv;
            n[2 * e] = dec * n[2 * e] + wi * ka; n[2 * e + 1] = dec * n[2 * e + 1] + wi * kb;
            num += C[2 * e] * qa + C[2 * e + 1] * qb; den += n[2 * e] * qa + n[2 * e + 1] * qb; }
        part[kg * 64 + dv] = num; if (dv == 0) partd[kg] = den;
        __syncthreads();
        if (tid < 64) { float s = 0.f, d = 0.f;
#pragma unroll
            for (int g = 0; g < 8; ++g) { s += part[g * 64 + tid]; d += partd[g]; }
            HML[tok * 1024 + h * 256 + dvs * 64 + tid] = (bf16)f2bf(s / fmaxf(fabsf(d), expf(-m))); }
        __syncthreads();
    }
}
#endif
__device__ __forceinline__ void headnorm_pass(const Ptrs& P, bf16* HML  , const bf16* SIGO, bf16* OATT  , int gw, int NGW, int lane) {
    float wa[16], wb[16];
#pragma unroll
    for (int e = 0; e < 16; ++e) { wa[e] = P.ml_norm_w[16 * lane + e]; wb[e] = P.da_norm_w[16 * lane + e] * 0.8f; }
    for (int m = gw; m < T; m += NGW) {
        { v4u* p = (v4u*)(HML + (size_t)m * 1024 + 16 * lane); const v4u a = p[0], b = p[1]; const v4u* sp = (const v4u*)(SIGO + (size_t)m * 1024 + 16 * lane); const v4u s0 = sp[0], s1 = sp[1];
          const unsigned xr[8] = {a.x, a.y, a.z, a.w, b.x, b.y, b.z, b.w}, sr[8] = {s0.x, s0.y, s0.z, s0.w, s1.x, s1.y, s1.z, s1.w};
          float x[16], sg[16]; float sum = 0.f;
#pragma unroll
          for (int e = 0; e < 8; ++e) { x[2 * e] = bflo(xr[e]); x[2 * e + 1] = bfhi(xr[e]); sg[2 * e] = bflo(sr[e]); sg[2 * e + 1] = bfhi(sr[e]); sum += x[2 * e] + x[2 * e + 1]; }
#pragma unroll
          for (int o = 1; o < 16; o <<= 1) sum += __shfl_xor(sum, o);
          const float mu = sum * (1.0f / 256.0f); float q = 0.f;
#pragma unroll
          for (int e = 0; e < 16; ++e) { x[e] -= mu; q += x[e] * x[e]; }
#pragma unroll
          for (int o = 1; o < 16; o <<= 1) q += __shfl_xor(q, o);
          const float rstd = 1.0f / sqrtf(q * (1.0f / 256.0f) + LN_EPS);
          unsigned ow[8];
#pragma unroll
          for (int e = 0; e < 8; ++e) ow[e] = pk2(x[2 * e] * rstd * wa[2 * e] * sg[2 * e], x[2 * e + 1] * rstd * wa[2 * e + 1] * sg[2 * e + 1]);
          p[0] = (v4u){ow[0], ow[1], ow[2], ow[3]}; p[1] = (v4u){ow[4], ow[5], ow[6], ow[7]}; }
        { v4u* p = (v4u*)(OATT + (size_t)m * 1024 + 16 * lane); const v4u a = p[0], b = p[1];
          const unsigned xr[8] = {a.x, a.y, a.z, a.w, b.x, b.y, b.z, b.w};
          float x[16]; float q = 0.f;
#pragma unroll
          for (int e = 0; e < 8; ++e) { x[2 * e] = bflo(xr[e]); x[2 * e + 1] = bfhi(xr[e]); q += x[2 * e] * x[2 * e] + x[2 * e + 1] * x[2 * e + 1]; }
#pragma unroll
          for (int o = 1; o < 8; o <<= 1) q += __shfl_xor(q, o);
          const float rs = 1.0f / sqrtf(q * (1.0f / 128.0f) + LN_EPS);
          unsigned ow[8];
#pragma unroll
          for (int e = 0; e < 8; ++e) ow[e] = pk2(x[2 * e] * rs * wb[2 * e], x[2 * e + 1] * rs * wb[2 * e + 1]);
          p[0] = (v4u){ow[0], ow[1], ow[2], ow[3]}; p[1] = (v4u){ow[4], ow[5], ow[6], ow[7]}; }
    }
}

__device__ __forceinline__ void ln_pass(const float* IN, const float* g, const float* bta, float* OUTF, bf16* OUTB, int gw, int NGW, int lane) {
    f32x4 gv[4], bv[4];
#pragma unroll
    for (int j = 0; j < 4; ++j) { gv[j] = ((const f32x4*)g)[lane + 64 * j]; bv[j] = ((const f32x4*)bta)[lane + 64 * j]; }
    for (int m = gw; m < T; m += NGW) {
        const f32x4* xr = (const f32x4*)(IN + (size_t)m * D) + lane;
        f32x4 v[4]; float s = 0.f;
#pragma unroll
        for (int j = 0; j < 4; ++j) { v[j] = xr[64 * j]; s += (v[j].x + v[j].y) + (v[j].z + v[j].w); }
        const float mean = wave_sum(s) * (1.f / D); float s2 = 0.f;
#pragma unroll
        for (int j = 0; j < 4; ++j) { v[j] = v[j] - mean; s2 += (v[j].x * v[j].x + v[j].y * v[j].y) + (v[j].z * v[j].z + v[j].w * v[j].w); }
        const float rstd = 1.f / sqrtf(wave_sum(s2) * (1.f / D) + LN_EPS);
        f32x4* of = (f32x4*)(OUTF + (size_t)m * D) + lane;
#pragma unroll
        for (int j = 0; j < 4; ++j) { v[j] = v[j] * rstd * gv[j] + bv[j]; of[64 * j] = v[j]; }
        if (OUTB) { unsigned long long* o8 = (unsigned long long*)(OUTB + (size_t)m * D) + lane;
#pragma unroll
            for (int j = 0; j < 4; ++j) o8[64 * j] = (unsigned long long)pk2(v[j].x, v[j].y) | ((unsigned long long)pk2(v[j].z, v[j].w) << 32); }
    }
}

#define MFMA32(a, b, c) __builtin_amdgcn_mfma_f32_32x32x16_bf16((a), (b), (c), 0, 0, 0)
__device__ __forceinline__ void xattn_unit(LAS unsigned char* lds, int b, int h, int qt, const bf16* XQ, const bf16* XK, const bf16* XVT, bf16* XO, int tid, int wid, int lane) {
    const int r32 = lane & 31, hi = lane >> 5;
    const size_t q = (size_t)b * SEQ + qt * 256 + wid * 32 + r32;
    const bf16* qp = XQ + q * 1024 + h * 256 + hi * 8;
    f32x16 s[8];
#pragma unroll
    for (int i = 0; i < 8; ++i)
#pragma unroll
        for (int r = 0; r < 16; ++r) s[i][r] = 0.f;
#pragma unroll
    for (int hf = 0; hf < 2; ++hf) {
        __syncthreads();
#pragma unroll
        for (int i = 0; i < 8; ++i) { const int p = tid + NTHR * i, row = p >> 5, sg = p & 31;
            *(LAS v4u*)(lds + row * 528 + sg * 16) = *(const v4u*)(XK + (size_t)(b * 256 + hf * 128 + row) * 1024 + h * 256 + sg * 8); }
        __syncthreads();
#pragma unroll 4
        for (int ks = 0; ks < 16; ++ks) { const bf16x8 qf = *(const bf16x8*)(qp + 16 * ks);
#pragma unroll
            for (int t = 0; t < 4; ++t) { const bf16x8 kf = *(const LAS bf16x8*)(lds + (32 * t + r32) * 528 + (16 * ks + 8 * hi) * 2); s[hf * 4 + t] = MFMA32(kf, qf, s[hf * 4 + t]); } }
    }
    float mx = s[0][0];
#pragma unroll
    for (int i = 0; i < 8; ++i)
#pragma unroll
        for (int r = 0; r < 16; ++r) mx = fmaxf(mx, s[i][r]);
    mx = fmaxf(mx, __shfl_xor(mx, 32));
    float l = 0.f;
#pragma unroll
    for (int i = 0; i < 8; ++i)
#pragma unroll
        for (int r = 0; r < 16; ++r) { s[i][r] = __builtin_amdgcn_exp2f(s[i][r] - mx); l += s[i][r]; }
    l += __shfl_xor(l, 32);
    const float rl = 1.0f / l;
    bf16x8 pf[8][2];
#pragma unroll
    for (int i = 0; i < 8; ++i)
#pragma unroll
        for (int st = 0; st < 2; ++st) { v4u w; w.x = pk2(s[i][8 * st], s[i][8 * st + 1]); w.y = pk2(s[i][8 * st + 2], s[i][8 * st + 3]); w.z = pk2(s[i][8 * st + 4], s[i][8 * st + 5]); w.w = pk2(s[i][8 * st + 6], s[i][8 * st + 7]);
            pf[i][st] = __builtin_bit_cast(bf16x8, w); }
#pragma unroll
    for (int dh = 0; dh < 2; ++dh) {
        __syncthreads();
#pragma unroll
        for (int i = 0; i < 8; ++i) { const int p = tid + NTHR * i, row = p >> 5, sg = p & 31;
            *(LAS v4u*)(lds + row * 528 + sg * 16) = *(const v4u*)(XVT + (size_t)(h * 256 + dh * 128 + row) * TM + b * 256 + sg * 8); }
        __syncthreads();
#pragma unroll
        for (int dt = 0; dt < 4; ++dt) { f32x16 o;
#pragma unroll
            for (int r = 0; r < 16; ++r) o[r] = 0.f;
#pragma unroll
            for (int i = 0; i < 8; ++i)
#pragma unroll
                for (int st = 0; st < 2; ++st) { const LAS unsigned char* vp = lds + (32 * dt + r32) * 528 + (32 * i + 16 * st + 4 * hi) * 2;
                    const s16x4 lo = *(const LAS s16x4*)vp, hi4 = *(const LAS s16x4*)(vp + 16);
                    const bf16x8 af = __builtin_shufflevector(lo, hi4, 0, 1, 2, 3, 4, 5, 6, 7); o = MFMA32(af, pf[i][st], o); }
#pragma unroll
            for (int g = 0; g < 4; ++g) { v2u w; w.x = pk2(o[4 * g] * rl, o[4 * g + 1] * rl); w.y = pk2(o[4 * g + 2] * rl, o[4 * g + 3] * rl);
                *(v2u*)(XO + q * 1024 + h * 256 + dh * 128 + 32 * dt + 8 * g + 4 * hi) = w; } }
    }
}

struct Args { const void* in[29]; float* out; unsigned char* ws; };

__global__ void __launch_bounds__(NTHR, 2) fwd_megakernel(Args args) {
    extern __shared__ __attribute__((aligned(16))) unsigned char lds_raw[];
    cg::grid_group grid = cg::this_grid();
#define GRID_SYNC() do { asm volatile("s_waitcnt vmcnt(0) lgkmcnt(0)" ::: "memory"); __syncthreads(); grid.sync(); \
        if (threadIdx.x < 64) asm volatile("buffer_inv sc1\n\ts_waitcnt vmcnt(0)" ::: "memory"); __syncthreads(); } while (0)
    LAS unsigned char* lds = (LAS unsigned char*)lds_raw;
    volatile LAS unsigned* bar_st = (volatile LAS unsigned*)(lds + LDS_BYTES - 64);
    if (threadIdx.x < 2) bar_st[threadIdx.x] = 0u;
    __syncthreads();
    const XcdBarrier xbar = xcd_barrier_post((unsigned*)(args.ws + WS_CTL), bar_st);
#define XCD_SYNC() xcd_barrier(xbar)
    const int G = gridDim.x, bx = blockIdx.x, NGW = G * NWAVES, NGT = G * NTHR;
#define FRESH() int tid = threadIdx.x; asm volatile("" : "+v"(tid)); const int lane = tid & 63, wave = __builtin_amdgcn_readfirstlane(tid >> 6), gw = bx * NWAVES + wave, gt = bx * NTHR + tid; (void)lane; (void)wave; (void)gw; (void)gt
    Ptrs P;
    P.x = (const float*)args.in[0]; P.mem = (const float*)args.in[1]; P.pos = (const int*)args.in[2]; P.w_in = (const float*)args.in[3]; P.b_in = (const float*)args.in[4];
    P.conv_w = (const float*)args.in[5]; P.conv_b = (const float*)args.in[6]; P.ml_norm_w = (const float*)args.in[7];
    P.lq1 = (const float*)args.in[8]; P.lk1 = (const float*)args.in[9]; P.lq2 = (const float*)args.in[10]; P.lk2 = (const float*)args.in[11]; P.da_norm_w = (const float*)args.in[12];
    P.wsq[0] = (const float*)args.in[13]; P.wsq[1] = (const float*)args.in[14]; P.wsq[2] = (const float*)args.in[15]; P.wsq[3] = (const float*)args.in[18]; P.wsq[4] = (const float*)args.in[19];
    P.wsq[5] = (const float*)args.in[20]; P.wsq[6] = (const float*)args.in[21];
    P.ln1g = (const float*)args.in[16]; P.ln1b = (const float*)args.in[17]; P.ln2g = (const float*)args.in[22]; P.ln2b = (const float*)args.in[23]; P.ln3g = (const float*)args.in[27]; P.ln3b = (const float*)args.in[28];
    P.w_gate = (const float*)args.in[24]; P.w_up = (const float*)args.in[25]; P.w_down = (const float*)args.in[26];
    P.out = args.out; P.ws = args.ws;
    unsigned char* ws = args.ws;
    bf16* const S0 = (bf16*)(ws + WS_S0); bf16* const S1 = (bf16*)(ws + WS_S1); bf16* const S2 = (bf16*)(ws + WS_S2); bf16* const S3 = (bf16*)(ws + WS_S3); bf16* const S4 = (bf16*)(ws + WS_S4); bf16* const S5 = (bf16*)(ws + WS_S5);
    bf16* const O0 = (bf16*)args.out; bf16* const O1 = (bf16*)((unsigned char*)args.out + 64 * MiB);
    bf16* const WSQ = (bf16*)(ws + WS_WSQ);
#define WSQ_(j) (WSQ + (size_t)(j) * 1024 * 1024)

#ifndef SKIP_P0
#ifndef REP_P0
#define REP_P0 1
#endif
    for (int rep_ = 0; rep_ < REP_P0; ++rep_)
{ FRESH(); p0_prologue(P, lds, gw, NGW, wave, lane, tid); }
#if defined(DIAG) && (DIAG == 9 || DIAG == 10)
    if (bx == 0 && threadIdx.x == 0) { ((float*)(ws + WS_CHK))[8192] = 0.0f; ((int*)(ws + WS_CHK))[8200] = 1000; ((int*)(ws + WS_CHK))[8201] = -1; }
#endif
#endif
    GRID_SYNC();

{ FRESH(); scan_step_a(ws, gw, NGW, lane); }
#ifndef REP_G1
#define REP_G1 1
#endif
    for (int rep_ = 0; rep_ < REP_G1; ++rep_)
    {
        pg8::Gemm g{S0, (const bf16*)(ws + WS_WIN1), T, 5120, D}; pg8::StaticOrder S; S.init(T, 5120, G, bx);
        pg8::EpiIn1 E{S1, S2, S3, S4, S5, P.b_in, (const float*)(ws + WS_COS), (const float*)(ws + WS_SIN), 0.125f * LOG2E};
        pg8::gemm_phase<pg8::EpiIn1, pg8::StaticOrder, true, true>(lds, g, S, E);
    }
    {
        pg8::Gemm g{(const bf16*)(ws + WS_MEMB), WSQ_(4), TM, D, D}; pg8::StaticOrder S; S.init(TM, D, G, bx);
        pg8::EpiPlain<0> E{(bf16*)(ws + WS_XK), D, nullptr, 1.0f};
        pg8::gemm_phase<pg8::EpiPlain<0>, pg8::StaticOrder, true, true>(lds, g, S, E);
    }
    {
        pg8::Gemm g{WSQ_(5), (const bf16*)(ws + WS_MEMB), D, TM, D}; pg8::StaticOrder S; S.init(D, TM, G, (bx + 128) % G);
        pg8::EpiPlain<0> E{(bf16*)(ws + WS_XVT), TM, nullptr, 1.0f};
        pg8::gemm_phase<pg8::EpiPlain<0>, pg8::StaticOrder, true, true>(lds, g, S, E);
    }
    XCD_SYNC();

{ FRESH(); scan_step_b(ws, tid); }
#ifndef SKIP_CONV
#ifndef REP_CONV
#define REP_CONV 1
#endif
    for (int rep_ = 0; rep_ < REP_CONV; ++rep_)
{ FRESH(); conv_pass(P, S1, O0, O0 + (size_t)T * 512, gt, NGT); }
#endif
    XCD_SYNC();

#ifndef SKIP_MLSTM
#ifndef REP_MLSTM
#define REP_MLSTM 1
#endif
    for (int rep_ = 0; rep_ < REP_MLSTM; ++rep_)
    for (int it = bx; it < 256; it += G) { FRESH();
#if defined(DIAG) && DIAG == 6
        mlstm_brute(lds, it >> 4, (it >> 2) & 3, it & 3, O0, O0 + (size_t)T * 512, S2, (const float*)(ws + WS_IFG), S1, tid); }
#else
        mlstm_item(lds, it >> 4, (it >> 2) & 3, it & 3, O0, O0 + (size_t)T * 512, S2, (const f32x4*)(ws + WS_SCT), (const float*)(ws + WS_CHK), (const float*)(ws + WS_MPREV), S1, tid, wave, lane); }
#endif
#endif
    {
        float s1, s2; { FRESH(); s1 = wave_sum(P.lq1[lane] * P.lk1[lane]); s2 = wave_sum(P.lq2[lane] * P.lk2[lane]); }
        const float lam = __int_as_float(__builtin_amdgcn_readfirstlane(__float_as_int(__expf(s1) - __expf(s2) + 0.2f)));
        __syncthreads();
#ifndef REP_ATTN
#define REP_ATTN 1
#endif
        for (int rep_ = 0; rep_ < REP_ATTN; ++rep_)
        for (int v = bx; v < 256; v += G) { const int b = v >> 4, h = (v >> 1) & 7, vh = v & 1;
#pragma clang loop unroll(disable)
            for (int i = 0; i < 16; ++i) { int c = i >> 3, qb = 7 - (i & 7); asm volatile("" : "+s"(c), "+s"(qb));
#ifndef SKIP_ATTN
                attn_body::attn_unit<8>(b, (2 * h + c) * 64, h * 128 + vh * 64, qb, (const attn_body::bf16*)S3, (const attn_body::bf16*)S4, (const attn_body::bf16*)S5, (attn_body::bf16*)O1, (char*)lds_raw, c == 1, lam);
#endif
            } }
    }
    XCD_SYNC();

    {
        pg8::Gemm g{S0, (const bf16*)(ws + WS_WIN2), T, 3072, D}; pg8::StaticOrder S; S.init(T, 3072, G, bx);
        pg8::EpiIn2 E{S2, S3, P.b_in};
        pg8::gemm_phase<pg8::EpiIn2, pg8::StaticOrder, true, true>(lds, g, S, E);
    }
    XCD_SYNC();

#if defined(DIAG) && DIAG == 10
    { FRESH(); float bad = 0.f;
      for (size_t i = gt; i < (size_t)T * D; i += NGT) { const float xv = P.x[i]; const float g = __uint_as_float((unsigned)S0[i] << 16); if (fabsf(g - xv) > 0.01f * fabsf(xv) + 1e-6f) bad += 1.f; }
      if (bad != 0.f) atomicAdd(&((float*)(ws + WS_CHK))[8192], bad); }
#endif
#if defined(DIAG) && DIAG == 9
    {
        FRESH();
        if (bx == 0) {
            float bad = 0.f;
            for (int i = tid; i < 4096; i += NTHR) {
                const int r = i & 255, c = (i * 37) % 3072;
                const int wcol = c < 1024 ? 2048 + c : 6152 + (c - 1024);
                float acc = P.b_in[wcol];
                for (int k = 0; k < D; ++k) acc += P.x[(size_t)r * D + k] * P.w_in[(size_t)k * INDIM + wcol];
                const float ref = 1.0f / (1.0f + expf(-acc));
                const unsigned short got16 = c < 1024 ? S2[(size_t)r * 1024 + c] : S3[(size_t)r * 2048 + (c - 1024)];
                const float got = __uint_as_float((unsigned)got16 << 16);
#ifndef PROBE_WHICH
#define PROBE_WHICH 0
#endif
                if (PROBE_WHICH == 5) { const int n = c, k = r & 1023; const int wc2 = n < 1024 ? 2048 + n : 6152 + (n - 1024);
                    const float wv = P.w_in[(size_t)k * INDIM + wc2]; const float gv2 = __uint_as_float((unsigned)((const bf16*)(ws + WS_WIN2))[(size_t)n * 1024 + k] << 16);
                    if (fabsf(gv2 - wv) > 0.01f * fabsf(wv) + 1e-6f) bad = 1.f; }
                else if (PROBE_WHICH == 4) { const int k = c & 1023; const float xv = P.x[(size_t)r * D + k]; const float gv2 = __uint_as_float((unsigned)S0[(size_t)r * 1024 + k] << 16);
                    if (fabsf(gv2 - xv) > 0.01f * fabsf(xv) + 1e-6f) bad = 1.f; }
                else
                if (PROBE_WHICH == 3) { const int c2 = c & 1023; float a2 = P.b_in[5128 + c2];
                    for (int k = 0; k < D; ++k) a2 += P.x[(size_t)r * D + k] * P.w_in[(size_t)k * INDIM + 5128 + c2];
                    const float g2 = __uint_as_float((unsigned)S5[(size_t)r * 1024 + c2] << 16);
                    if (fabsf(g2 - a2) > 0.06f) bad = 1.f; }
                else
                if ((PROBE_WHICH == 0 || (PROBE_WHICH == 1 && c < 1024) || (PROBE_WHICH == 2 && c >= 1024)) && fabsf(got - ref) > 0.02f) { bad += 1.f; atomicMin((int*)(ws + WS_CHK) + 8200, r >> 8); atomicMax((int*)(ws + WS_CHK) + 8201, r >> 8); }
            }
            if (bad != 0.f) atomicAdd(&((float*)(ws + WS_CHK))[8192], bad);
        }
    }
#endif
#ifndef SKIP_HN
{ FRESH(); headnorm_pass(P, S1, S2, O1, gw, NGW, lane); }
#if defined(DIAG) && (DIAG == 1 || DIAG == 2)
    XCD_SYNC();
    { FRESH(); v4u* p = (v4u*)(DIAG == 1 ? (bf16*)S1 : (bf16*)O1); for (size_t i = gt; i < (size_t)T * 1024 / 8; i += NGT) p[i] = (v4u){0u, 0u, 0u, 0u}; }
#endif
#endif
    XCD_SYNC();

    {
        pg8::Gemm g{S1, WSQ_(0), T, D, D}; pg8::StaticOrder S; S.init(T, D, G, bx);
        pg8::EpiGate<false> E{S2, S3, nullptr};
        pg8::gemm_phase<pg8::EpiGate<false>, pg8::StaticOrder, true, true>(lds, g, S, E);
    }
    {
        pg8::Gemm g{O1, WSQ_(1), T, D, D}; pg8::StaticOrder S; S.init(T, D, G, bx);
        pg8::EpiGate<true> E{S5, S3, S2};
        pg8::gemm_phase<pg8::EpiGate<true>, pg8::StaticOrder, true, true>(lds, g, S, E);
    }
    XCD_SYNC();

#if defined(DIAG) && DIAG == 7
    { FRESH(); v4u* p = (v4u*)S5; for (size_t i = gt; i < (size_t)T * 1024 / 8; i += NGT) p[i] = (v4u){0u, 0u, 0u, 0u}; }
    XCD_SYNC();
#endif
#ifndef REP_G4
#define REP_G4 1
#endif
    for (int rep_ = 0; rep_ < REP_G4; ++rep_)
    {
        pg8::Gemm g{S5, WSQ_(2), T, D, D}; pg8::StaticOrder S; S.init(T, D, G, bx);
        pg8::EpiRes E{P.x, (float*)S1, ALPHA};
        pg8::gemm_phase<pg8::EpiRes, pg8::StaticOrder, true, true>(lds, g, S, E);
    }
    XCD_SYNC();
#ifndef REP_LN1
#define REP_LN1 1
#endif
    for (int rep_ = 0; rep_ < REP_LN1; ++rep_)
{ FRESH(); ln_pass((const float*)S1, P.ln1g, P.ln1b, (float*)S3, S0, gw, NGW, lane); }
    XCD_SYNC();

    {
        pg8::Gemm g{S0, WSQ_(3), T, D, D}; pg8::StaticOrder S; S.init(T, D, G, bx);
        pg8::EpiPlain<0> E{S5, D, nullptr, 0.0625f * LOG2E};
        pg8::gemm_phase<pg8::EpiPlain<0>, pg8::StaticOrder, true, true>(lds, g, S, E);
    }
    XCD_SYNC();

#ifndef SKIP_XATTN
#ifndef REP_XATTN
#define REP_XATTN 1
#endif
    for (int rep_ = 0; rep_ < REP_XATTN; ++rep_)
    for (int u = bx; u < 512; u += G) { FRESH(); xattn_unit(lds, u >> 5, (u >> 3) & 3, u & 7, S5, (const bf16*)(ws + WS_XK), (const bf16*)(ws + WS_XVT), S1, tid, wave, lane); }
#endif
    __syncthreads();
#if defined(DIAG) && DIAG == 3
    XCD_SYNC();
    { FRESH(); v4u* p = (v4u*)S1; for (size_t i = gt; i < (size_t)T * 1024 / 8; i += NGT) p[i] = (v4u){0u, 0u, 0u, 0u}; }
#endif
    XCD_SYNC();

    {
        pg8::Gemm g{S1, WSQ_(6), T, D, D}; pg8::StaticOrder S; S.init(T, D, G, bx);
        pg8::EpiRes E{(const float*)S3, args.out, ALPHA};
        pg8::gemm_phase<pg8::EpiRes, pg8::StaticOrder, true, true>(lds, g, S, E);
    }
    XCD_SYNC();
{ FRESH(); ln_pass(args.out, P.ln2g, P.ln2b, args.out, S0, gw, NGW, lane); }
    XCD_SYNC();

#ifndef REP_G8
#define REP_G8 1
#endif
    for (int rep_ = 0; rep_ < REP_G8; ++rep_)
    {
        pg8::Gemm g{S0, (const bf16*)(ws + WS_WGU), T, 2 * FF, D}; pg8::StaticOrder S; S.init(T, 2 * FF, G, bx);
        pg8::EpiSwiglu E{S1, FF};
        pg8::gemm_phase<pg8::EpiSwiglu, pg8::StaticOrder, true, true>(lds, g, S, E);
    }
    XCD_SYNC();

#if defined(DIAG) && DIAG == 4
    { FRESH(); v4u* p = (v4u*)S1; for (size_t i = gt; i < (size_t)T * FF / 8; i += NGT) p[i] = (v4u){0u, 0u, 0u, 0u}; }
    XCD_SYNC();
#endif
#ifndef REP_G9
#define REP_G9 1
#endif
    for (int rep_ = 0; rep_ < REP_G9; ++rep_)
    {
        pg8::Gemm g{S1, (const bf16*)(ws + WS_WDN), T, D, FF}; pg8::StaticOrder S; S.init(T, D, G, bx);
        pg8::EpiRes E{args.out, (float*)S4, ALPHA};
        pg8::gemm_phase<pg8::EpiRes, pg8::StaticOrder, true, true>(lds, g, S, E);
    }
    XCD_SYNC();
{ FRESH(); ln_pass((const float*)S4, P.ln3g, P.ln3b, args.out, nullptr, gw, NGW, lane); }
#if defined(DIAG) && (DIAG == 9 || DIAG == 10)
    XCD_SYNC();
    if (bx == 0 && threadIdx.x == 0) { const float cnt = ((float*)(ws + WS_CHK))[8192]; args.out[0] = cnt > 0.f ? exp2f(3.0f + log2f(cnt)) : 4.0f; }
#endif
}

extern "C" void kernel_launch(void* const* d_in, const int* in_sizes, int n_in, void* d_out, int out_size, void* d_ws, size_t ws_size, hipStream_t stream) {
    static int grid = 0;
    if (grid == 0) {
        if (n_in != 29 || out_size != T * D || ws_size < WS_END) { fprintf(stderr, "kernel_launch: unexpected problem (n_in %d, out %d, ws %zu); nothing launched\n", n_in, out_size, ws_size); grid = -1; return; }
        int dev = 0, cus = 0, per_cu = 0;
        if (hipGetDevice(&dev) != hipSuccess || hipDeviceGetAttribute(&cus, hipDeviceAttributeMultiprocessorCount, dev) != hipSuccess) { grid = -1; return; }
        if (hipFuncSetAttribute((const void*)fwd_megakernel, hipFuncAttributeMaxDynamicSharedMemorySize, LDS_BYTES) != hipSuccess) { fprintf(stderr, "kernel_launch: hipFuncSetAttribute failed\n"); grid = -1; return; }
        if (hipOccupancyMaxActiveBlocksPerMultiprocessor(&per_cu, (const void*)fwd_megakernel, NTHR, LDS_BYTES) != hipSuccess || per_cu < 1) { fprintf(stderr, "kernel_launch: occupancy query gave %d\n", per_cu); per_cu = 1; }
        (void)hipGetLastError();
        grid = cus * per_cu;
        fprintf(stderr, "kernel_launch: grid %d (cus %d x %d), ws %zu\n", grid, cus, per_cu, ws_size);
    }
    if (grid < 0) return;
    if (hipMemsetAsync((unsigned char*)d_ws + WS_CTL, 0, CTL_BYTES, stream) != hipSuccess) { fprintf(stderr, "kernel_launch: memset of the barrier words failed\n"); return; }
    Args a{};
    for (int i = 0; i < 29; ++i) a.in[i] = d_in[i];
    a.out = (float*)d_out; a.ws = (unsigned char*)d_ws;
    void* kargs[] = {&a};
    const hipError_t e = hipLaunchCooperativeKernel((const void*)fwd_megakernel, dim3(grid), dim3(NTHR), kargs, LDS_BYTES, stream);
    if (e != hipSuccess) fprintf(stderr, "kernel_launch: cooperative launch failed: %s (grid %d)\n", hipGetErrorString(e), grid);
}
```
